# Optimizing an MI355X kernel written in HIP

```python
import math, functools
import jax, jax.numpy as jnp
from jax import lax
import numpy as np

D_MODEL = 1024
BATCH = 32
SEQ = 2048
DEPTH = 1
DEC_BATCH = 1
DEC_SEQ = 16384
PAST_LEN = 128

HEAD_DIM = 128
HEADS_PER_GROUP = 4
DILATION_GROUPS = ((128, 1), (512, 4), (2048, 16))
N_GROUPS = len(DILATION_GROUPS)
N_ATTN_HEADS = N_GROUPS * HEADS_PER_GROUP
ATTN_WIDTH = N_ATTN_HEADS * HEAD_DIM
ATTN_OUT_WIDTH = HEADS_PER_GROUP * HEAD_DIM
BAND_BLOCK = 64
N_BUCKETS = 32
MAX_DISTANCE = 1024
HYENA_WIDTH = D_MODEL
HYENA_ORDER = 2
SHORT_CONV = 3
FILTER_BANDS = 16
FILTER_EMB_DIM = 2 * FILTER_BANDS + 1
FILTER_HIDDEN = 64
N_FILTER_CH = HYENA_ORDER * 2 * HYENA_WIDTH
FILTER_OUT_SCALE = 0.02
DECAY_TARGET = 1e-2
FAST_DECAY_PCT = 0.3
SLOW_DECAY_PCT = 1.5
N_BRANCHES = 2
D_FF = 4 * D_MODEL
IN_WIDTH = 3 * ATTN_WIDTH + (HYENA_ORDER + 1) * HYENA_WIDTH + N_BRANCHES * D_MODEL
NORM_EPS = 1e-6
MASK_VALUE = -1e30

kernel_name = 'hybrid_dilated_attn_hyena_encoder'


def rms_norm(x, g):
    xf = x.astype(jnp.float32)
    y = xf * lax.rsqrt(jnp.mean(xf * xf, axis=-1, keepdims=True) + NORM_EPS)
    return (y * g.astype(jnp.float32)).astype(x.dtype)


def t5_bucket(rel):
    nb = N_BUCKETS // 2
    max_exact = nb // 2
    side = jnp.where(rel > 0, nb, 0)
    n = jnp.abs(rel)
    nf = jnp.maximum(n, 1).astype(jnp.float32)
    large = max_exact + (jnp.log(nf / max_exact) / math.log(MAX_DISTANCE / max_exact)
                         * (nb - max_exact)).astype(jnp.int32)
    large = jnp.minimum(large, nb - 1)
    return side + jnp.where(n < max_exact, n, large)


def dilated_band_attention(q, k, v, bias_table, dil, radius):
    B, L, G, hd = q.shape
    M = L // dil
    nblk = -(-M // BAND_BLOCK)
    Mp = nblk * BAND_BLOCK

    def to_sub(t):
        return t.reshape(B, M, dil, G, hd).transpose(0, 2, 1, 3, 4)

    def windows(t):
        tp = jnp.pad(t, ((0, 0), (0, 0), (BAND_BLOCK, Mp - M + BAND_BLOCK), (0, 0), (0, 0)))
        tp = tp.reshape(B, dil, nblk + 2, BAND_BLOCK, G, hd)
        return jnp.concatenate([tp[:, :, :-2], tp[:, :, 1:-1], tp[:, :, 2:]], axis=3)

    qs = jnp.pad(to_sub(q), ((0, 0), (0, 0), (0, Mp - M), (0, 0), (0, 0)))
    qb = qs.reshape(B, dil, nblk, BAND_BLOCK, G, hd)
    kw = windows(to_sub(k))
    vw = windows(to_sub(v))

    scores = jnp.einsum('bdnqgh,bdnkgh->bdngqk', qb, kw,
                        preferred_element_type=jnp.float32) * (HEAD_DIM ** -0.5)
    qi = jnp.arange(BAND_BLOCK)[:, None]
    kj = jnp.arange(3 * BAND_BLOCK)[None, :]
    delta = kj - BAND_BLOCK - qi
    bias = bias_table[t5_bucket(delta * dil)].astype(jnp.float32)
    bias = bias.transpose(2, 0, 1)
    key_m = jnp.arange(nblk)[:, None, None] * BAND_BLOCK - BAND_BLOCK + kj[None]
    valid = (jnp.abs(delta) <= radius)[None] & (key_m >= 0) & (key_m < M)
    scores = jnp.where(valid[:, None], scores + bias, MASK_VALUE)

    mx = jnp.max(scores, axis=-1, keepdims=True)
    p = jnp.exp(scores - mx)
    den = jnp.sum(p, axis=-1, keepdims=True)
    out = jnp.einsum('bdngqk,bdnkgh->bdnqgh', (p / den).astype(v.dtype), vw)
    lse = (mx + jnp.log(den))[..., 0]

    out = out.reshape(B, dil, Mp, G, hd)[:, :, :M].transpose(0, 2, 1, 3, 4).reshape(B, L, G, hd)
    lse = lse.transpose(0, 1, 2, 4, 3).reshape(B, dil, Mp, G)[:, :, :M]
    lse = lse.transpose(0, 2, 1, 3).reshape(B, L, G)
    return out.astype(jnp.float32), lse


def short_conv3(u, w, b):
    up = jnp.pad(u, ((0, 0), (1, 1), (0, 0)))
    return up[:, :-2] * w[0] + up[:, 1:-1] * w[1] + up[:, 2:] * w[2] + b


def hyena_filters(L, w1, b1, w2, b2, w3, b3, w4, freq):
    f32 = jnp.float32
    t = jnp.linspace(0.0, 1.0, L, dtype=f32)[:, None]
    ang = 2.0 * math.pi * jnp.arange(L, dtype=f32)[:, None] / L
    bands = jnp.linspace(1e-4, FILTER_BANDS - 1, FILTER_BANDS, dtype=f32)[None, :]
    z = jnp.concatenate([t, jnp.cos(bands * ang), -jnp.sin(bands * ang)], axis=-1)
    fr = freq.astype(f32)
    h = jnp.sin(fr * (z @ w1.astype(f32) + b1.astype(f32)))
    h = jnp.sin(fr * (h @ w2.astype(f32) + b2.astype(f32)))
    h = jnp.sin(fr * (h @ w3.astype(f32) + b3.astype(f32)))
    h = (h @ w4.astype(f32)).reshape(L, HYENA_ORDER, 2, HYENA_WIDTH)
    min_decay = math.log(DECAY_TARGET) / SLOW_DECAY_PCT
    max_decay = math.log(DECAY_TARGET) / FAST_DECAY_PCT
    deltas = jnp.linspace(min_decay, max_decay, HYENA_WIDTH, dtype=f32)
    decay = jnp.exp(-t * jnp.abs(deltas)[None, :])
    return h * decay[:, None, None, :]


def bidir_long_conv(z, h_fwd, h_bwd, skip):
    L = z.shape[1]
    k2 = jnp.concatenate([h_fwd, jnp.zeros_like(h_fwd[:1]), h_bwd[:0:-1]], axis=0)
    zf = z.astype(jnp.float32)
    spec = jnp.fft.rfft(zf, n=2 * L, axis=1) * jnp.fft.rfft(k2, axis=0)[None]
    y = jnp.fft.irfft(spec, n=2 * L, axis=1)[:, :L]
    return (y + zf * skip.astype(jnp.float32)).astype(z.dtype)


def encoder_layer(x, rel_bias, g_mix, w_in, g_q, g_k, w_attn_branch, w_short, b_short,
                  filt_w1, filt_b1, filt_w2, filt_b2, filt_w3, filt_b3, filt_w4, filt_freq,
                  filt_skip, w_hyena_branch, w_out, g_mlp, w_ff1, w_ff2):
    B, L, _ = x.shape
    h = rms_norm(x, g_mix)
    proj = h @ w_in
    q, k, v, hy, gate_logits = jnp.split(
        proj, [ATTN_WIDTH, 2 * ATTN_WIDTH, 3 * ATTN_WIDTH,
               3 * ATTN_WIDTH + (HYENA_ORDER + 1) * HYENA_WIDTH], axis=-1)

    q = rms_norm(q.reshape(B, L, N_ATTN_HEADS, HEAD_DIM), g_q)
    k = rms_norm(k.reshape(B, L, N_ATTN_HEADS, HEAD_DIM), g_k)
    v = v.reshape(B, L, N_ATTN_HEADS, HEAD_DIM)
    outs, lses = [], []
    for gi, (window, dil) in enumerate(DILATION_GROUPS):
        hs = slice(gi * HEADS_PER_GROUP, (gi + 1) * HEADS_PER_GROUP)
        o, s = dilated_band_attention(q[:, :, hs], k[:, :, hs], v[:, :, hs],
                                      rel_bias[:, hs], dil, window // (2 * dil))
        outs.append(o)
        lses.append(s)
    wgt = jax.nn.softmax(jnp.stack(lses, axis=2), axis=2)
    attn = jnp.einsum('blngh,blng->blgh', jnp.stack(outs, axis=2), wgt)
    attn_branch = attn.reshape(B, L, ATTN_OUT_WIDTH).astype(x.dtype) @ w_attn_branch

    hy = short_conv3(hy, w_short, b_short)
    z, *hy_gates = jnp.split(hy, HYENA_ORDER + 1, axis=-1)
    filt = hyena_filters(L, filt_w1, filt_b1, filt_w2, filt_b2, filt_w3, filt_b3, filt_w4, filt_freq)
    for n in range(HYENA_ORDER):
        z = hy_gates[n] * bidir_long_conv(z, filt[:, n, 0], filt[:, n, 1], filt_skip[n])
    hyena_branch = z @ w_hyena_branch

    g_attn, g_hyena = jnp.split(gate_logits, N_BRANCHES, axis=-1)
    merged = jax.nn.sigmoid(g_attn) * attn_branch + jax.nn.sigmoid(g_hyena) * hyena_branch
    x = x + merged @ w_out

    hm = rms_norm(x, g_mlp)
    return x + jnp.square(jax.nn.relu(hm @ w_ff1)) @ w_ff2


def setup_inputs(seed: int = 0) -> dict:
    key = jax.random.key(seed)
    ks = jax.random.split(key, 32)

    def nrm(k, shape, scale):
        return jax.random.normal(k, shape, jnp.float32) * scale

    HW = HYENA_WIDTH
    return {
        'x_prompt': nrm(ks[0], (BATCH, SEQ, D_MODEL), 1.0),
        'x_sample': nrm(ks[1], (DEC_BATCH, DEC_SEQ, D_MODEL), 1.0),
        'rel_bias': nrm(ks[2], (N_BUCKETS, N_ATTN_HEADS), 0.1),
        'g_mix': 1.0 + nrm(ks[3], (DEPTH, D_MODEL), 0.1),
        'w_in': nrm(ks[4], (DEPTH, D_MODEL, IN_WIDTH), D_MODEL ** -0.5),
        'g_q': 1.0 + nrm(ks[5], (DEPTH, HEAD_DIM), 0.1),
        'g_k': 1.0 + nrm(ks[6], (DEPTH, HEAD_DIM), 0.1),
        'w_attn_branch': nrm(ks[7], (DEPTH, ATTN_OUT_WIDTH, D_MODEL), ATTN_OUT_WIDTH ** -0.5),
        'w_short': nrm(ks[8], (DEPTH, SHORT_CONV, (HYENA_ORDER + 1) * HW), SHORT_CONV ** -0.5),
        'b_short': nrm(ks[9], (DEPTH, (HYENA_ORDER + 1) * HW), 0.02),
        'filt_w1': nrm(ks[10], (DEPTH, FILTER_EMB_DIM, FILTER_HIDDEN), FILTER_EMB_DIM ** -0.5),
        'filt_b1': nrm(ks[11], (DEPTH, FILTER_HIDDEN), 0.1),
        'filt_w2': nrm(ks[12], (DEPTH, FILTER_HIDDEN, FILTER_HIDDEN), FILTER_HIDDEN ** -0.5),
        'filt_b2': nrm(ks[13], (DEPTH, FILTER_HIDDEN), 0.1),
        'filt_w3': nrm(ks[14], (DEPTH, FILTER_HIDDEN, FILTER_HIDDEN), FILTER_HIDDEN ** -0.5),
        'filt_b3': nrm(ks[15], (DEPTH, FILTER_HIDDEN), 0.1),
        'filt_w4': nrm(ks[16], (DEPTH, FILTER_HIDDEN, N_FILTER_CH), FILTER_OUT_SCALE * FILTER_HIDDEN ** -0.5),
        'filt_freq': 1.0 + nrm(ks[17], (DEPTH, FILTER_HIDDEN), 0.1),
        'filt_skip': 1.0 + nrm(ks[18], (DEPTH, HYENA_ORDER, HW), 0.1),
        'w_hyena_branch': nrm(ks[19], (DEPTH, HW, D_MODEL), HW ** -0.5),
        'w_out': nrm(ks[20], (DEPTH, D_MODEL, D_MODEL), D_MODEL ** -0.5),
        'g_mlp': 1.0 + nrm(ks[21], (DEPTH, D_MODEL), 0.1),
        'w_ff1': nrm(ks[22], (DEPTH, D_MODEL, D_FF), D_MODEL ** -0.5),
        'w_ff2': nrm(ks[23], (DEPTH, D_FF, D_MODEL), D_FF ** -0.5),
    }


def reference(x_prompt, x_sample, rel_bias, g_mix, w_in, g_q, g_k, w_attn_branch, w_short,
              b_short, filt_w1, filt_b1, filt_w2, filt_b2, filt_w3, filt_b3, filt_w4,
              filt_freq, filt_skip, w_hyena_branch, w_out, g_mlp, w_ff1, w_ff2):
    y_prompt = x_prompt
    y_sample = x_sample
    for l in range(DEPTH):
        layer = functools.partial(
            encoder_layer, rel_bias=rel_bias, g_mix=g_mix[l], w_in=w_in[l], g_q=g_q[l],
            g_k=g_k[l], w_attn_branch=w_attn_branch[l], w_short=w_short[l],
            b_short=b_short[l], filt_w1=filt_w1[l], filt_b1=filt_b1[l], filt_w2=filt_w2[l],
            filt_b2=filt_b2[l], filt_w3=filt_w3[l], filt_b3=filt_b3[l], filt_w4=filt_w4[l],
            filt_freq=filt_freq[l], filt_skip=filt_skip[l],
            w_hyena_branch=w_hyena_branch[l], w_out=w_out[l], g_mlp=g_mlp[l],
            w_ff1=w_ff1[l], w_ff2=w_ff2[l])
        y_prompt = layer(y_prompt)
        y_sample = layer(y_sample)
    return (y_prompt, y_sample)
```

```cpp
#include <hip/hip_runtime.h>
#include <hip/hip_cooperative_groups.h>
#include <cstdio>
namespace cg = cooperative_groups;

#define LAS __attribute__((address_space(3)))
#define GAS __attribute__((address_space(1)))
typedef unsigned short u16;
typedef short bf16x8 __attribute__((ext_vector_type(8)));
typedef short s16x4 __attribute__((ext_vector_type(4)));
typedef float f32x4 __attribute__((ext_vector_type(4)));
typedef float f32x16 __attribute__((ext_vector_type(16)));
typedef unsigned u32x4 __attribute__((ext_vector_type(4)));
typedef unsigned u32x2 __attribute__((ext_vector_type(2)));

#ifndef N_LAUNCH_MODE
#define N_LAUNCH_MODE 1
#endif

constexpr int DM = 1024, TALL = 81920, TS = 16384, NSL = 5, INW = 9728, DFF = 4096;
constexpr int NPOS = 2048 + 16384;
constexpr int LDS_BYTES = 147456;

constexpr size_t al256(size_t x) { return (x + 255) & ~(size_t)255; }
constexpr size_t O_WIN = 0;
constexpr size_t O_WAB = O_WIN + (size_t)INW * DM * 2;
constexpr size_t O_WHB = O_WAB + (size_t)DM * 512 * 2;
constexpr size_t O_WOUT = O_WHB + (size_t)DM * DM * 2;
constexpr size_t O_WF1 = O_WOUT + (size_t)DM * DM * 2;
constexpr size_t O_WF2 = O_WF1 + (size_t)DFF * DM * 2;
constexpr size_t O_W4 = O_WF2 + (size_t)DFF * DM * 2;
constexpr size_t O_H3 = O_W4 + (size_t)4096 * 256 * 2;
constexpr size_t O_G2K = O_H3 + (size_t)NPOS * 256 * 2;
constexpr size_t O_G16K = O_G2K + (size_t)2 * 1024 * 4096 * 2;
constexpr size_t O_XB = O_G16K + (size_t)2 * 1024 * 32768 * 2;
constexpr size_t O_RSTD1 = O_XB + (size_t)TALL * DM * 2;
constexpr size_t O_SSQ2 = O_RSTD1 + (size_t)TALL * 4;
constexpr size_t O_BIAS = O_SSQ2 + (size_t)TALL * 64;
constexpr size_t O_QKV = O_BIAS + 8192;
constexpr size_t O_HYT = O_QKV + (size_t)TS * 4608 * 2;
constexpr size_t O_SG = O_HYT + (size_t)3072 * TS * 2;
constexpr size_t SG_BYTES = (size_t)TS * 2048 * 2;
constexpr size_t O_O3 = O_SG + 2 * SG_BYTES;
constexpr size_t O_LSE = O_O3 + (size_t)3 * TS * 512 * 2;
constexpr size_t O_ATT = O_LSE + (size_t)3 * TS * 4 * 4;
constexpr size_t O_ZT = O_ATT + (size_t)TS * 512 * 2;
constexpr size_t O_ZR = O_ZT + (size_t)1024 * TS * 2;
constexpr size_t O_MG = O_ZR + (size_t)TS * 1024 * 2;
constexpr size_t O_CTR = O_MG + (size_t)TALL * 1024 * 2;
constexpr size_t O_RSTD2 = O_CTR + 256;
constexpr size_t WS_END = O_RSTD2 + (size_t)TALL * 4;
static_assert(WS_END <= (size_t)1073741824, "workspace budget");
constexpr size_t O_X2B = O_XB;
constexpr size_t HB_BYTES = (size_t)TS * DFF * 2;
constexpr size_t O_HB = O_QKV;
static_assert(O_HB + 2 * HB_BYTES <= O_MG, "hidden buffers alias only per-slice mixer buffers");

struct Params {
  const float* in[24];
  float* out;
  unsigned char* ws;
  int ph_lo, ph_hi;
};
enum { I_XP = 0, I_XS, I_RELB, I_GMIX, I_WIN, I_GQ, I_GK, I_WAB, I_WSH, I_BSH, I_FW1, I_FB1, I_FW2, I_FB2, I_FW3, I_FB3, I_FW4, I_FFR, I_FSK, I_WHB, I_WOUT, I_GMLP, I_WF1, I_WF2 };

#define LAUNDER_V(x) asm volatile("" : "+v"(x))
#define LAUNDER_S(x) asm volatile("" : "+s"(x))
__device__ __forceinline__ float bf2f(unsigned v) { return __uint_as_float(v << 16); }
typedef __bf16 bf16x2_t __attribute__((ext_vector_type(2)));
typedef float f32x2_t __attribute__((ext_vector_type(2)));
__device__ __forceinline__ unsigned pk2(float lo, float hi) { const f32x2_t f = {lo, hi}; const bf16x2_t b = __builtin_convertvector(f, bf16x2_t); return __builtin_bit_cast(unsigned, b); }
__device__ __forceinline__ float lo16(unsigned v) { return __uint_as_float(v << 16); }
__device__ __forceinline__ float hi16(unsigned v) { return __uint_as_float(v & 0xffff0000u); }

namespace pg8 {
constexpr int BM = 256, BK = 64, HALF = 128, HTB = HALF * BK * 2, STAGE_BYTES = 8 * HTB, NXCD = 8, WGM = 8;
__device__ __forceinline__ int lds_byte(int r, int c) { const int st = (r >> 4) * 2 + (c >> 5), rr = r & 15, cc = c & 31, ob = rr * 64 + cc * 2; return st * 1024 + (ob ^ (((ob >> 9) & 1) << 5)); }
__device__ __forceinline__ void stage_rc(int b, int& R, int& C) { const int st = b / 1024, sb = b % 1024, swz = sb ^ (((sb >> 9) & 1) << 5); R = (st >> 1) * 16 + swz / 64; C = (st & 1) * 32 + (swz % 64) / 2; }
__device__ __forceinline__ int perm32(int rho) { const int n = rho >> 4, i = rho & 15; return 8 * (i >> 2) + 4 * n + (i & 3); }
struct Unit { int pm, pn, swap; };
struct Gemm { const u16* A; const u16* Bt; int M, N, K; };
struct StaticOrder {
  int nM, nN, nwg, G, c, slo, shi;
  __device__ void init(int M, int N, int G_, int c_, int slo_, int shi_) { nM = M / BM; nN = N / BM; nwg = nM * nN; G = G_; c = c_; slo = slo_; shi = shi_; }
  __device__ bool next(int i, Unit& u) const {
    const long L = (long)i * G + c; if (L >= nwg) return false;
    int wgid = (int)L; { const int q = nwg / NXCD, r = nwg % NXCD, xcd = wgid % NXCD, off = wgid / NXCD; wgid = (xcd < r ? xcd * (q + 1) : r * (q + 1) + (xcd - r) * q) + off; }
    const int nig = WGM * nN, gid = wgid / nig, fm = gid * WGM, gsz = (nM - fm) < WGM ? (nM - fm) : WGM;
    u.pm = fm + ((wgid % nig) % gsz); u.pn = (wgid % nig) / gsz; u.swap = (u.pn >= slo && u.pn < shi) ? 1 : 0; return true;
  }
};

template <class Epi>
__device__ __forceinline__ void gemm_phase(LAS unsigned char* lds, const Gemm g, const StaticOrder& S, const Epi& E) {
  int tid = threadIdx.x; LAUNDER_V(tid);
  const int wid = __builtin_amdgcn_readfirstlane(tid >> 6), lane = tid & 63, wr = wid >> 2, wc = wid & 3, fr = lane & 15, fq = lane >> 4;
  const int K = g.K, nt = K / BK;
  unsigned voffA[2], voffB[2];
#pragma unroll
  for (int i = 0; i < 2; ++i) { int R, C; stage_rc(tid * 16 + i * 8192, R, C); const int Rb = (R & ~31) + perm32(R & 31);
    voffA[i] = (unsigned)(R * K + C) * 2u; voffB[i] = (unsigned)(Rb * K + C) * 2u; }
  const size_t kstep = (size_t)(BK * 2);
  const size_t hstep = (size_t)HALF * K * 2;
  const size_t tstep = 2 * hstep;
  const unsigned ldsw = (unsigned)wid * 1024u;
  const int aoff = lds_byte(wr * 64 + fr, fq * 8), boff = lds_byte(wc * 32 + fr, fq * 8);
#define PG8_SA(b, h) (((b) * 2 + (h)) * HTB)
#define PG8_SB(b, h) ((4 + (b) * 2 + (h)) * HTB)
#define PG8_STAGE(bufoff, gbase, voff) do { _Pragma("unroll") for (int _i = 0; _i < 2; ++_i) \
    __builtin_amdgcn_global_load_lds((const unsigned*)((const char*)(gbase) + (voff)[_i]), (LAS unsigned*)(lds + (bufoff) + ldsw + _i * 8192), 16, 0, 0); } while (0)
#define PG8_LDA(dst, b, h) do { _Pragma("unroll") for (int m = 0; m < 4; ++m) _Pragma("unroll") for (int k = 0; k < 2; ++k) dst[m][k] = *(const LAS bf16x8*)(lds + PG8_SA(b, h) + aoff + m * 2048 + k * 1024); } while (0)
#define PG8_LDB(dst, b, h) do { _Pragma("unroll") for (int n = 0; n < 2; ++n) _Pragma("unroll") for (int k = 0; k < 2; ++k) dst[n][k] = *(const LAS bf16x8*)(lds + PG8_SB(b, h) + boff + n * 2048 + k * 1024); } while (0)
#define PG8_MMA(ai, bj, At, Bt) do { __builtin_amdgcn_s_setprio(1); _Pragma("unroll") for (int m = 0; m < 4; ++m) _Pragma("unroll") for (int n = 0; n < 2; ++n) _Pragma("unroll") for (int k = 0; k < 2; ++k) \
    acc[ai][bj][m][n] = __builtin_amdgcn_mfma_f32_16x16x32_bf16(Bt[n][k], At[m][k], acc[ai][bj][m][n], 0, 0, 0); __builtin_amdgcn_s_setprio(0); } while (0)
#define PG8_WAIT_V(n) asm volatile("s_waitcnt vmcnt(" #n ")" ::: "memory")
#define PG8_WAIT_L(n) asm volatile("s_waitcnt lgkmcnt(" #n ")" ::: "memory")
#define PG8_BAR __builtin_amdgcn_s_barrier()
#define PG8_SCHED __builtin_amdgcn_sched_barrier(0)
  Unit cur, nxt; int ui = 0;
  if (!S.next(0, cur)) return;
  f32x4 acc[2][2][4][2];
#pragma unroll
  for (int a = 0; a < 2; ++a)
#pragma unroll
    for (int b = 0; b < 2; ++b)
#pragma unroll
      for (int m = 0; m < 4; ++m)
#pragma unroll
        for (int n = 0; n < 2; ++n) acc[a][b][m][n] = (f32x4){0.f, 0.f, 0.f, 0.f};
  bf16x8 At[4][2], B0[2][2], B1[2][2];
  const char* pAm = (const char*)g.A + (size_t)cur.pm * tstep; const char* pBn = (const char*)g.Bt + (size_t)cur.pn * tstep;
  const char* cA = cur.swap ? pBn : pAm; const char* cB = cur.swap ? pAm : pBn;
  PG8_STAGE(PG8_SB(0, 0), cB, voffB); PG8_STAGE(PG8_SA(0, 0), cA, voffA); PG8_STAGE(PG8_SB(0, 1), cB + hstep, voffB); PG8_STAGE(PG8_SA(0, 1), cA + hstep, voffA);
  if (wr == 1) PG8_BAR;
  PG8_WAIT_V(4); PG8_BAR;
  PG8_STAGE(PG8_SB(1, 0), cB + kstep, voffB); PG8_STAGE(PG8_SA(1, 0), cA + kstep, voffA); PG8_STAGE(PG8_SB(1, 1), cB + hstep + kstep, voffB);
  PG8_WAIT_V(6); PG8_BAR;
  for (;;) {
    const bool has_next = S.next(ui + 1, nxt);
    const char* nA = cA; const char* nB = cB;
    if (has_next) { const char* qa = (const char*)g.A + (size_t)nxt.pm * tstep; const char* qb = (const char*)g.Bt + (size_t)nxt.pn * tstep; nA = nxt.swap ? qb : qa; nB = nxt.swap ? qa : qb; }
    for (int t = 0; t < nt; t += 2) {
      const bool last = (t == nt - 2);
      const char* a1 = cA + (size_t)(t + 1) * kstep;
      const char* a2 = last ? nA : cA + (size_t)(t + 2) * kstep; const char* b2 = last ? nB : cB + (size_t)(t + 2) * kstep;
      const char* a3 = a2 + kstep; const char* b3 = b2 + kstep;
      PG8_LDB(B0, 0, 0); PG8_SCHED; PG8_LDA(At, 0, 0); PG8_STAGE(PG8_SA(1, 1), a1 + hstep, voffA);
      PG8_WAIT_L(8); PG8_BAR; PG8_WAIT_L(0); PG8_MMA(0, 0, At, B0); PG8_BAR; PG8_SCHED;
      PG8_LDB(B1, 0, 1); PG8_STAGE(PG8_SB(0, 0), b2, voffB);
      PG8_BAR; PG8_WAIT_L(0); PG8_MMA(0, 1, At, B1); PG8_BAR;
      PG8_LDA(At, 0, 1); PG8_STAGE(PG8_SA(0, 0), a2, voffA);
      PG8_BAR; PG8_WAIT_L(0); PG8_MMA(1, 0, At, B0); PG8_BAR; PG8_SCHED;
      PG8_STAGE(PG8_SB(0, 1), b2 + hstep, voffB);
      PG8_WAIT_V(6); PG8_BAR; PG8_MMA(1, 1, At, B1); PG8_BAR;
      PG8_LDB(B0, 1, 0); PG8_SCHED; PG8_LDA(At, 1, 0); PG8_STAGE(PG8_SA(0, 1), a2 + hstep, voffA);
      PG8_WAIT_L(8); PG8_BAR; PG8_WAIT_L(0); PG8_MMA(0, 0, At, B0); PG8_BAR; PG8_SCHED;
      PG8_LDB(B1, 1, 1); PG8_STAGE(PG8_SB(1, 0), b3, voffB);
      PG8_BAR; PG8_WAIT_L(0); PG8_MMA(0, 1, At, B1); PG8_BAR;
      PG8_LDA(At, 1, 1); PG8_STAGE(PG8_SA(1, 0), a3, voffA);
      PG8_BAR; PG8_WAIT_L(0); PG8_MMA(1, 0, At, B0); PG8_BAR; PG8_SCHED;
      PG8_STAGE(PG8_SB(1, 1), b3 + hstep, voffB);
      PG8_WAIT_V(6); PG8_BAR; PG8_MMA(1, 1, At, B1); PG8_BAR;
    }
    E(acc, cur, wr, wc, fr, fq);
    if (!has_next) break;
#pragma unroll
    for (int a = 0; a < 2; ++a)
#pragma unroll
      for (int b = 0; b < 2; ++b)
#pragma unroll
        for (int m = 0; m < 4; ++m)
#pragma unroll
          for (int n = 0; n < 2; ++n) acc[a][b][m][n] = (f32x4){0.f, 0.f, 0.f, 0.f};
    cur = nxt; cA = nA; cB = nB; ++ui;
  }
  PG8_WAIT_V(0);
  if (wr == 0) PG8_BAR;
  PG8_BAR;
#undef PG8_SA
#undef PG8_SB
#undef PG8_STAGE
#undef PG8_LDA
#undef PG8_LDB
#undef PG8_MMA
#undef PG8_WAIT_V
#undef PG8_WAIT_L
#undef PG8_BAR
#undef PG8_SCHED
}
}

enum { EM_FILT = 0, EM_INPROJ, EM_AB, EM_HBR, EM_OUT, EM_FF1, EM_FF2 };
struct Epi {
  int mode, slice; const Params* P; unsigned char* wsl;
  __device__ __forceinline__ void operator()(const f32x4 (&acc)[2][2][4][2], const pg8::Unit& u, int wr, int wc, int fr, int fq) const {
    unsigned char* ws = wsl;
    const int prow = u.swap ? u.pn : u.pm, pcol = u.swap ? u.pm : u.pn;
    const int row0 = prow * 256 + wr * 64 + fr, col0 = pcol * 256 + wc * 32 + 8 * fq;
    if (mode == EM_FILT) {
      const float dmin = 3.0701134573253945f, dmax = 15.350567286626973f;
#pragma unroll
      for (int bj = 0; bj < 2; ++bj) {
        const int pr = col0 + bj * 128; const int L = pr < 2048 ? 2048 : 16384; const int p0 = pr < 2048 ? pr : pr - 2048;
        u16* G = (u16*)(ws + (L == 2048 ? O_G2K : O_G16K));
        const float tinv = 1.0f / (float)(L - 1);
#pragma unroll
        for (int ai = 0; ai < 2; ++ai)
#pragma unroll
          for (int m = 0; m < 4; ++m) {
            const int fc = row0 + ai * 128 + m * 16; const int order = fc >> 11, dir = (fc >> 10) & 1, c = fc & 1023;
            const float dl = dmin + (dmax - dmin) * ((float)c * (1.0f / 1023.0f));
            float v[8]; float dk = __expf(-(float)p0 * tinv * dl); const float dstep = __expf(-tinv * dl);
#pragma unroll
            for (int e = 0; e < 8; ++e) { v[e] = acc[ai][bj][m][e >> 2][e & 3] * dk; dk *= dstep; }
            u16* base = G + (size_t)(order * 1024 + c) * (size_t)(2 * L);
            u32x4 o;
            if (dir == 0) { o.x = pk2(v[7], v[6]); o.y = pk2(v[5], v[4]); o.z = pk2(v[3], v[2]); o.w = pk2(v[1], v[0]); *(u32x4*)(base + (L - 8 - p0)) = o; }
            else { o.x = pk2(v[0], v[1]); o.y = pk2(v[2], v[3]); o.z = pk2(v[4], v[5]); o.w = pk2(v[6], v[7]); *(u32x4*)(base + (L + p0)) = o; }
          }
      }
    } else if (mode == EM_INPROJ) {
      const float* rstd1 = (const float*)(ws + O_RSTD1) + (size_t)slice * TS;
      if (u.swap) {
        u16* hyT = (u16*)(ws + O_HYT);
        f32x4 rr[2][2];
#pragma unroll
        for (int bj = 0; bj < 2; ++bj) { rr[bj][0] = *(const f32x4*)(rstd1 + col0 + bj * 128); rr[bj][1] = *(const f32x4*)(rstd1 + col0 + bj * 128 + 4); }
        __builtin_amdgcn_sched_barrier(0);
#pragma unroll
        for (int bj = 0; bj < 2; ++bj) {
          const int tok0 = col0 + bj * 128;
#pragma unroll
          for (int ai = 0; ai < 2; ++ai)
#pragma unroll
            for (int m = 0; m < 4; ++m) {
              const int ch = row0 + ai * 128 + m * 16 - 4608;
              const f32x4 a = acc[ai][bj][m][0] * rr[bj][0], b = acc[ai][bj][m][1] * rr[bj][1];
              u32x4 o; o.x = pk2(a[0], a[1]); o.y = pk2(a[2], a[3]); o.z = pk2(b[0], b[1]); o.w = pk2(b[2], b[3]);
              *(u32x4*)(hyT + (size_t)ch * TS + tok0) = o;
            }
        }
      } else {
        u16* qkv = (u16*)(ws + O_QKV); u16* sg = (u16*)(ws + O_SG + (size_t)(slice & 1) * SG_BYTES);
        const bool isg = (u.pn >= 30);
        float rsv[2][4];
#pragma unroll
        for (int ai = 0; ai < 2; ++ai)
#pragma unroll
          for (int m = 0; m < 4; ++m) rsv[ai][m] = rstd1[row0 + ai * 128 + m * 16];
        __builtin_amdgcn_sched_barrier(0);
#pragma unroll
        for (int ai = 0; ai < 2; ++ai)
#pragma unroll
          for (int m = 0; m < 4; ++m) {
            const int row = row0 + ai * 128 + m * 16; const float rs = rsv[ai][m];
#pragma unroll
            for (int bj = 0; bj < 2; ++bj) {
              const int c = col0 + bj * 128;
              f32x4 a = acc[ai][bj][m][0] * rs, b = acc[ai][bj][m][1] * rs;
              if (isg) {
#pragma unroll
                for (int e = 0; e < 4; ++e) { a[e] = __builtin_amdgcn_rcpf(1.0f + __expf(-a[e])); b[e] = __builtin_amdgcn_rcpf(1.0f + __expf(-b[e])); }
              }
              u32x4 o; o.x = pk2(a[0], a[1]); o.y = pk2(a[2], a[3]); o.z = pk2(b[0], b[1]); o.w = pk2(b[2], b[3]);
              if (isg) *(u32x4*)(sg + (size_t)row * 2048 + (c - 7680)) = o; else *(u32x4*)(qkv + (size_t)row * 4608 + c) = o;
            }
          }
      }
    } else if (mode == EM_AB || mode == EM_HBR) {
      const u16* sg = (const u16*)(ws + O_SG + (size_t)(slice & 1) * SG_BYTES) + (mode == EM_HBR ? 1024 : 0); u16* mg = (u16*)(ws + O_MG) + (size_t)slice * TS * 1024;
#pragma unroll
      for (int g8 = 0; g8 < 4; ++g8) {
        const int ai = g8 >> 1, m0 = (g8 & 1) * 2;
        u32x4 sv[2][2], pv[2][2];
#pragma unroll
        for (int mm = 0; mm < 2; ++mm)
#pragma unroll
          for (int bj = 0; bj < 2; ++bj) {
            const int row = row0 + ai * 128 + (m0 + mm) * 16, c = col0 + bj * 128;
            sv[mm][bj] = *(const u32x4*)(sg + (size_t)row * 2048 + c);
            if (mode == EM_HBR) pv[mm][bj] = *(const u32x4*)(mg + (size_t)row * 1024 + c);
          }
        __builtin_amdgcn_sched_barrier(0);
#pragma unroll
        for (int mm = 0; mm < 2; ++mm)
#pragma unroll
          for (int bj = 0; bj < 2; ++bj) {
            const int m = m0 + mm, row = row0 + ai * 128 + m * 16, c = col0 + bj * 128;
            const u32x4 sx = sv[mm][bj];
            const f32x4 a = acc[ai][bj][m][0], b = acc[ai][bj][m][1];
            float v[8] = {a[0] * lo16(sx.x), a[1] * hi16(sx.x), a[2] * lo16(sx.y), a[3] * hi16(sx.y), b[0] * lo16(sx.z), b[1] * hi16(sx.z), b[2] * lo16(sx.w), b[3] * hi16(sx.w)};
            if (mode == EM_HBR) { const u32x4 p = pv[mm][bj];
              v[0] += lo16(p.x); v[1] += hi16(p.x); v[2] += lo16(p.y); v[3] += hi16(p.y); v[4] += lo16(p.z); v[5] += hi16(p.z); v[6] += lo16(p.w); v[7] += hi16(p.w); }
            u32x4 o; o.x = pk2(v[0], v[1]); o.y = pk2(v[2], v[3]); o.z = pk2(v[4], v[5]); o.w = pk2(v[6], v[7]);
            *(u32x4*)(mg + (size_t)row * 1024 + c) = o;
          }
        __builtin_amdgcn_sched_barrier(0);
      }
    } else if (mode == EM_OUT) {
      const float* xin = (u.pm < 256) ? P->in[I_XP] : P->in[I_XS] - (size_t)65536 * DM;
      u16* x2b = (u16*)(ws + O_X2B);
      float* ssq = (float*)(ws + O_SSQ2);
#pragma unroll
      for (int g8 = 0; g8 < 4; ++g8) {
        const int ai = g8 >> 1, m0 = (g8 & 1) * 2;
        f32x4 xa[2][2][2];
#pragma unroll
        for (int mm = 0; mm < 2; ++mm)
#pragma unroll
          for (int bj = 0; bj < 2; ++bj) {
            const float* xp = xin + (size_t)(row0 + ai * 128 + (m0 + mm) * 16) * DM + col0 + bj * 128;
            xa[mm][bj][0] = *(const f32x4*)xp; xa[mm][bj][1] = *(const f32x4*)(xp + 4);
          }
        __builtin_amdgcn_sched_barrier(0);
#pragma unroll
        for (int mm = 0; mm < 2; ++mm) {
          const int m = m0 + mm, row = row0 + ai * 128 + m * 16; float sq = 0.f;
#pragma unroll
          for (int bj = 0; bj < 2; ++bj) {
            const int c = col0 + bj * 128;
            const f32x4 a = acc[ai][bj][m][0] + xa[mm][bj][0], b = acc[ai][bj][m][1] + xa[mm][bj][1];
            u32x4 o; o.x = pk2(a[0], a[1]); o.y = pk2(a[2], a[3]); o.z = pk2(b[0], b[1]); o.w = pk2(b[2], b[3]);
            *(u32x4*)(x2b + (size_t)row * DM + c) = o;
            sq += a[0] * a[0] + a[1] * a[1] + a[2] * a[2] + a[3] * a[3] + b[0] * b[0] + b[1] * b[1] + b[2] * b[2] + b[3] * b[3];
          }
          sq += __shfl_xor(sq, 16); sq += __shfl_xor(sq, 32);
          if (fq == 0) ssq[(size_t)(u.pn * 4 + wc) * TALL + row] = sq;
        }
        __builtin_amdgcn_sched_barrier(0);
      }
    } else if (mode == EM_FF1) {
      const float* rs2 = (const float*)(ws + O_RSTD2) + (size_t)slice * TS; u16* hb = (u16*)(ws + O_HB + (size_t)(slice & 1) * HB_BYTES);
      float rsv[2][4];
#pragma unroll
      for (int ai = 0; ai < 2; ++ai)
#pragma unroll
        for (int m = 0; m < 4; ++m) rsv[ai][m] = rs2[row0 + ai * 128 + m * 16];
      __builtin_amdgcn_sched_barrier(0);
#pragma unroll
      for (int ai = 0; ai < 2; ++ai)
#pragma unroll
        for (int m = 0; m < 4; ++m) {
          const int row = row0 + ai * 128 + m * 16; const float rs = rsv[ai][m];
#pragma unroll
          for (int bj = 0; bj < 2; ++bj) {
            const int c = col0 + bj * 128;
            f32x4 a = acc[ai][bj][m][0] * rs, b = acc[ai][bj][m][1] * rs;
#pragma unroll
            for (int e = 0; e < 4; ++e) { a[e] = fmaxf(a[e], 0.f); a[e] *= a[e]; b[e] = fmaxf(b[e], 0.f); b[e] *= b[e]; }
            u32x4 o; o.x = pk2(a[0], a[1]); o.y = pk2(a[2], a[3]); o.z = pk2(b[0], b[1]); o.w = pk2(b[2], b[3]);
            *(u32x4*)(hb + (size_t)row * DFF + c) = o;
          }
        }
    } else {
      float* xo = P->out + (size_t)slice * TS * DM; const u16* x2b = (const u16*)(ws + O_X2B) + (size_t)slice * TS * DM;
#pragma unroll
      for (int ai = 0; ai < 2; ++ai) {
        u32x4 xv[4][2];
#pragma unroll
        for (int m = 0; m < 4; ++m)
#pragma unroll
          for (int bj = 0; bj < 2; ++bj) xv[m][bj] = *(const u32x4*)(x2b + (size_t)(row0 + ai * 128 + m * 16) * DM + col0 + bj * 128);
        __builtin_amdgcn_sched_barrier(0);
#pragma unroll
        for (int m = 0; m < 4; ++m) {
          const int row = row0 + ai * 128 + m * 16;
#pragma unroll
          for (int bj = 0; bj < 2; ++bj) {
            float* d = xo + (size_t)row * DM + col0 + bj * 128;
            const u32x4 x4 = xv[m][bj];
            f32x4 o0 = acc[ai][bj][m][0], o1 = acc[ai][bj][m][1];
            o0[0] += lo16(x4.x); o0[1] += hi16(x4.x); o0[2] += lo16(x4.y); o0[3] += hi16(x4.y); o1[0] += lo16(x4.z); o1[1] += hi16(x4.z); o1[2] += lo16(x4.w); o1[3] += hi16(x4.w);
            *(f32x4*)d = o0; *(f32x4*)(d + 4) = o1;
          }
        }
        __builtin_amdgcn_sched_barrier(0);
      }
    }
  }
};

__device__ __forceinline__ void run_gemm(const Params& P, LAS unsigned char* lds, const u16* A, const u16* Bt, int M, int N, int K, int mode, int slice, int slo, int shi) {
  pg8::Gemm g; g.A = A; g.Bt = Bt; g.M = M; g.N = N; g.K = K;
  pg8::StaticOrder S; S.init(M, N, (int)gridDim.x, (int)blockIdx.x, slo, shi);
  Epi E; E.mode = mode; E.slice = slice; E.P = &P; { unsigned char* w = P.ws; LAUNDER_S(w); E.wsl = w; }
  pg8::gemm_phase<Epi>(lds, g, S, E);
}

__device__ __forceinline__ float red2pi(float x) { const float k = rintf(x * 0.15915494309189535f); float r = fmaf(-k, 6.28125f, x); return fmaf(-k, 1.9353071795864769e-3f, r); }
__device__ __forceinline__ float psin(float x) { const float r = red2pi(x); const float r2 = r * r;
  const float hx = 0.5f * r, h2 = hx * hx;
  const float sh = hx * (1.0f + h2 * (-1.6666667e-1f + h2 * (8.3333333e-3f + h2 * (-1.9841270e-4f + h2 * (2.7557319e-6f + h2 * (-2.5052108e-8f))))));
  const float ch = 1.0f + h2 * (-0.5f + h2 * (4.1666667e-2f + h2 * (-1.3888889e-3f + h2 * (2.4801587e-5f + h2 * (-2.7557319e-7f + h2 * 2.0876757e-9f)))));
  (void)r2; return 2.0f * sh * ch; }
__device__ __forceinline__ float pcos(float x) { const float r = red2pi(x); const float hx = 0.5f * r, h2 = hx * hx;
  const float sh = hx * (1.0f + h2 * (-1.6666667e-1f + h2 * (8.3333333e-3f + h2 * (-1.9841270e-4f + h2 * (2.7557319e-6f + h2 * (-2.5052108e-8f))))));
  return 1.0f - 2.0f * sh * sh; }
__device__ __forceinline__ void transpose_tile(const float* W, int K, int N, u16* WT, int ldo, const float* g, int tile, LAS float* scr) {
  int tid = threadIdx.x; LAUNDER_V(tid); const int ntn = N / 64, kb = tile / ntn, nb = tile % ntn, k0 = kb * 64, n0 = nb * 64;
#pragma unroll
  for (int i = 0; i < 8; ++i) { const int kk = (tid >> 6) + 8 * i, nn = tid & 63; float v = W[(size_t)(k0 + kk) * N + n0 + nn]; if (g) v *= g[k0 + kk]; scr[kk * 65 + nn] = v; }
  __syncthreads();
  { const int n = tid >> 3, c = tid & 7; const LAS float* s = scr + (8 * c) * 65 + n;
    u32x4 o; o.x = pk2(s[0], s[65]); o.y = pk2(s[130], s[195]); o.z = pk2(s[260], s[325]); o.w = pk2(s[390], s[455]);
    *(u32x4*)(WT + (size_t)(n0 + n) * ldo + k0 + 8 * c) = o; }
  __syncthreads();
}

__device__ __forceinline__ void phase_prep(const Params& P, LAS unsigned char* lds) {
  unsigned char* ws = P.ws; LAUNDER_S(ws); int tid = threadIdx.x; LAUNDER_V(tid); const int bid = blockIdx.x, G = gridDim.x;
  LAS float* scr = (LAS float*)lds;
  {
    const int T_IN = 16 * 152, T_AB = 8 * 16, T_HB = 16 * 16, T_OUT = 16 * 16, T_F1 = 16 * 64, T_F2 = 64 * 16, T_W4 = 1 * 64;
    const int NT = T_IN + T_AB + T_HB + T_OUT + T_F1 + T_F2 + T_W4;
    for (int it = bid; it < NT; it += G) {
      int r = it; const float* W; int K, N, ldo; size_t off; const float* gg = nullptr;
      if (r < T_IN) { W = P.in[I_WIN]; K = 1024; N = INW; off = O_WIN; ldo = 1024; gg = P.in[I_GMIX]; }
      else if ((r -= T_IN) < T_AB) { W = P.in[I_WAB]; K = 512; N = 1024; off = O_WAB; ldo = 512; }
      else if ((r -= T_AB) < T_HB) { W = P.in[I_WHB]; K = 1024; N = 1024; off = O_WHB; ldo = 1024; }
      else if ((r -= T_HB) < T_OUT) { W = P.in[I_WOUT]; K = 1024; N = 1024; off = O_WOUT; ldo = 1024; }
      else if ((r -= T_OUT) < T_F1) { W = P.in[I_WF1]; K = 1024; N = 4096; off = O_WF1; ldo = 1024; gg = P.in[I_GMLP]; }
      else if ((r -= T_F1) < T_F2) { W = P.in[I_WF2]; K = 4096; N = 1024; off = O_WF2; ldo = 4096; }
      else { r -= T_F2; W = P.in[I_FW4]; K = 64; N = 4096; off = O_W4; ldo = 256; }
      transpose_tile(W, K, N, (u16*)(ws + off), ldo, gg, r, scr);
    }
    for (int i = bid * 512 + tid; i < 4096 * 24; i += G * 512) { const int n = i / 24, c = i % 24; unsigned z0 = 0u; LAUNDER_V(z0); *(u32x4*)((u16*)(ws + O_W4) + (size_t)n * 256 + 64 + 8 * c) = (u32x4){z0, z0, z0, z0}; }
  }
  {
    const int wave = tid >> 6, lane = tid & 63; u16* xb = (u16*)(ws + O_XB); float* rstd1 = (float*)(ws + O_RSTD1);
    for (int chunk = bid; chunk < TALL / 32; chunk += G) {
#pragma unroll 1
      for (int rr = 0; rr < 4; ++rr) {
        const int row = chunk * 32 + wave * 4 + rr;
        const float* src = row < 65536 ? P.in[I_XP] + (size_t)row * DM : P.in[I_XS] + (size_t)(row - 65536) * DM;
        f32x4 v[4]; float s = 0.f;
#pragma unroll
        for (int j = 0; j < 4; ++j) { v[j] = *(const f32x4*)(src + 4 * lane + 256 * j); s += v[j][0] * v[j][0] + v[j][1] * v[j][1] + v[j][2] * v[j][2] + v[j][3] * v[j][3]; }
#pragma unroll
        for (int o = 1; o < 64; o <<= 1) s += __shfl_xor(s, o);
#pragma unroll
        for (int j = 0; j < 4; ++j) { u32x2 o; o.x = pk2(v[j][0], v[j][1]); o.y = pk2(v[j][2], v[j][3]); *(u32x2*)(xb + (size_t)row * DM + 4 * lane + 256 * j) = o; }
        if (lane == 0) rstd1[row] = rsqrtf(s * (1.0f / 1024.0f) + 1e-6f);
      }
    }
  }
  if (bid == 0) {
    float* bt = (float*)(ws + O_BIAS);
    for (int i = tid; i < 12 * 129; i += 512) {
      const int h = i / 129, e = i % 129, delta = e - 64, gi = h >> 2, dil = 1 << (2 * gi), rel = delta * dil;
      const int side = rel > 0 ? 16 : 0, n = rel < 0 ? -rel : rel;
      int bucket;
      if (n < 8) bucket = n; else { int lg = 8 + (int)(__log2f((float)n * 0.125f) * (8.0f / 7.0f)); bucket = lg < 15 ? lg : 15; }
      bt[i] = P.in[I_RELB][(side + bucket) * 12 + h];
    }
  }
  {
    LAS float* zf = scr + 4160; LAS float* ha = zf + 8 * 36; LAS float* hb = ha + 8 * 64;
    const int pp = tid >> 6, j = tid & 63; u16* h3 = (u16*)(ws + O_H3);
    const float* w1 = P.in[I_FW1]; const float* w2 = P.in[I_FW2]; const float* w3 = P.in[I_FW3];
    const float fr = P.in[I_FFR][j], b1 = P.in[I_FB1][j], b2 = P.in[I_FB2][j], b3 = P.in[I_FB3][j];
    for (int it = bid; it < NPOS / 8; it += G) {
      const int r = it * 8 + pp; const int L = r < 2048 ? 2048 : 16384; const int i = r < 2048 ? r : r - 2048;
      if (j < 33) {
        const float ang = (6.2831853071795864f * (float)i) / (float)L; float z;
        if (j == 0) z = (float)i / (float)(L - 1);
        else { const int bi = (j - 1) & 15; const float band = 1e-4f + (float)bi * ((15.0f - 1e-4f) / 15.0f); z = (j <= 16) ? pcos(band * ang) : -psin(band * ang); }
        zf[pp * 36 + j] = z;
      }
      __syncthreads();
      { float a = b1;
_Pragma("unroll 3")
        for (int k = 0; k < 33; ++k) a += zf[pp * 36 + k] * w1[k * 64 + j]; ha[pp * 64 + j] = psin(fr * a); }
      __syncthreads();
      { float a = b2;
_Pragma("unroll 4")
        for (int k = 0; k < 64; ++k) a += ha[pp * 64 + k] * w2[k * 64 + j]; hb[pp * 64 + j] = psin(fr * a); }
      __syncthreads();
      { float a = b3;
_Pragma("unroll 4")
        for (int k = 0; k < 64; ++k) a += hb[pp * 64 + k] * w3[k * 64 + j]; const float v = psin(fr * a);
        u16* d = h3 + (size_t)r * 256; d[j] = (u16)(pk2(v, 0.f) & 0xffffu); d[64 + j] = 0; d[128 + j] = 0; d[192 + j] = 0; }
      __syncthreads();
    }
  }
}

constexpr int KROW = 272;
constexpr int KHALF = 256 * KROW;
__device__ __forceinline__ void stage_kv(const u16* src_base_  , int b, int L, int dil, int r, int m0, int M, LAS unsigned char* img, const float* gk, int ht) {
  const GAS u16* src_base = (const GAS u16*)src_base_;
  const int dch = ht & 15;
  float gv[8];
  if (gk) {
#pragma unroll
    for (int e = 0; e < 8; ++e) gv[e] = gk[dch * 8 + e];
  }
  u32x4 vv[16];
#pragma unroll
  for (int it = 0; it < 16; ++it) {
    const int kl = (ht >> 4) + 16 * it; int m = m0 - 64 + kl; m = m < 0 ? 0 : (m > M - 1 ? M - 1 : m);
    vv[it] = *(const GAS u32x4*)(src_base + (size_t)(b * L + m * dil + r) * 4608 + dch * 8);
  }
#pragma unroll
  for (int it = 0; it < 16; ++it) {
    const int kl = (ht >> 4) + 16 * it, m = m0 - 64 + kl; const bool valid = (m >= 0) && (m < M);
    u32x4 v = vv[it];
    if (!valid) { v.x = 0u; LAUNDER_V(v.x); v.y = v.x; v.z = v.x; v.w = v.x; }
    if (gk) {
      float f[8] = {lo16(v.x), hi16(v.x), lo16(v.y), hi16(v.y), lo16(v.z), hi16(v.z), lo16(v.w), hi16(v.w)};
      float s = 0.f;
#pragma unroll
      for (int e = 0; e < 8; ++e) s += f[e] * f[e];
      s += __shfl_xor(s, 1); s += __shfl_xor(s, 2); s += __shfl_xor(s, 4); s += __shfl_xor(s, 8);
      const float rs = rsqrtf(s * (1.0f / 128.0f) + 1e-6f);
      v.x = pk2(f[0] * rs * gv[0], f[1] * rs * gv[1]); v.y = pk2(f[2] * rs * gv[2], f[3] * rs * gv[3]);
      v.z = pk2(f[4] * rs * gv[4], f[5] * rs * gv[5]); v.w = pk2(f[6] * rs * gv[6], f[7] * rs * gv[7]);
    }
    *(LAS u32x4*)(img + kl * KROW + dch * 16) = v;
  }
}

__device__ __forceinline__ void attn_item(const Params& P, int slice, int item, LAS unsigned char* lds) {
  unsigned char* ws = P.ws; LAUNDER_S(ws); int tid = threadIdx.x; LAUNDER_V(tid);
  const int wave = __builtin_amdgcn_readfirstlane(tid >> 6), lane = tid & 63, half = wave >> 2, wq = wave & 3, ht = tid & 255, qn = lane & 31, h = lane >> 5;
  const int L = slice < 4 ? 2048 : 16384;
  const int hi = item * 2 + half, gi = hi >> 9, rem = hi & 511, g = rem >> 7, ci = rem & 127;
  const int dil = 1 << (2 * gi), M = L / dil, cps = L >> 7, b = ci / cps, cr = ci % cps, cpr = M >> 7, r = cr / cpr, chunk = cr % cpr, m0 = chunk * 128, head = gi * 4 + g;
  const u16* qkv = (const u16*)(ws + O_QKV);
  LAS unsigned char* img = lds + half * KHALF;
  LAS float* bl = (LAS float*)(lds + 2 * KHALF + half * 1024);
  stage_kv(qkv + 1536 + head * 128, b, L, dil, r, m0, M, img, P.in[I_GK], ht);
  if (ht < 129) bl[ht] = ((const float*)(ws + O_BIAS))[head * 129 + ht];
  const int mq = m0 + 32 * wq + qn, tokq = b * L + mq * dil + r;
  bf16x8 Qf[8];
  {
    u32x4 qv[8]; float s = 0.f;
#pragma unroll
    for (int ks = 0; ks < 8; ++ks) { qv[ks] = *(const u32x4*)(qkv + (size_t)tokq * 4608 + head * 128 + 16 * ks + 8 * h);
      const float f0 = lo16(qv[ks].x), f1 = hi16(qv[ks].x), f2 = lo16(qv[ks].y), f3 = hi16(qv[ks].y), f4 = lo16(qv[ks].z), f5 = hi16(qv[ks].z), f6 = lo16(qv[ks].w), f7 = hi16(qv[ks].w);
      s += f0 * f0 + f1 * f1 + f2 * f2 + f3 * f3 + f4 * f4 + f5 * f5 + f6 * f6 + f7 * f7; }
    s += __shfl_xor(s, 32);
    const float rs = rsqrtf(s * (1.0f / 128.0f) + 1e-6f) * 0.08838834764831845f;
    const float* gq = P.in[I_GQ];
#pragma unroll
    for (int ks = 0; ks < 8; ++ks) {
      const f32x4 g0 = *(const f32x4*)(gq + 16 * ks + 8 * h), g1 = *(const f32x4*)(gq + 16 * ks + 8 * h + 4);
      u32x4 o; o.x = pk2(lo16(qv[ks].x) * rs * g0[0], hi16(qv[ks].x) * rs * g0[1]); o.y = pk2(lo16(qv[ks].y) * rs * g0[2], hi16(qv[ks].y) * rs * g0[3]);
      o.z = pk2(lo16(qv[ks].z) * rs * g1[0], hi16(qv[ks].z) * rs * g1[1]); o.w = pk2(lo16(qv[ks].w) * rs * g1[2], hi16(qv[ks].w) * rs * g1[3]);
      Qf[ks] = __builtin_bit_cast(bf16x8, o);
    }
  }
  __syncthreads();
  f32x16 sc[5];
#pragma unroll
  for (int kt = 0; kt < 5; ++kt) {
#pragma unroll
    for (int i = 0; i < 16; ++i) sc[kt][i] = 0.f;
    const LAS unsigned char* kp = img + (32 * wq + 32 * kt + qn) * KROW + 16 * h;
#pragma unroll
    for (int ks = 0; ks < 8; ++ks) { const bf16x8 a = *(const LAS bf16x8*)(kp + 32 * ks); sc[kt] = __builtin_amdgcn_mfma_f32_32x32x16_bf16(a, Qf[ks], sc[kt], 0, 0, 0); }
  }
  float mx = -3.0e38f;
#pragma unroll
  for (int kt = 0; kt < 5; ++kt)
#pragma unroll
    for (int i = 0; i < 16; ++i) {
      const int keyl = 32 * kt + (i & 3) + 8 * (i >> 2) + 4 * h; const int delta = keyl - 64 - qn; const int km = m0 - 64 + 32 * wq + keyl;
      const bool valid = (delta >= -64) && (delta <= 64) && (km >= 0) && (km < M);
      int bi = delta + 64; bi = bi < 0 ? 0 : (bi > 128 ? 128 : bi);
      const float sv = valid ? sc[kt][i] + bl[bi] : -1e30f;
      sc[kt][i] = sv; mx = fmaxf(mx, sv);
    }
  mx = fmaxf(mx, __shfl_xor(mx, 32));
  float den = 0.f;
#pragma unroll
  for (int kt = 0; kt < 5; ++kt)
#pragma unroll
    for (int i = 0; i < 16; ++i) { const float pe = __expf(sc[kt][i] - mx); sc[kt][i] = pe; den += pe; }
  den += __shfl_xor(den, 32);
  const float inv = 1.0f / den;
  if (h == 0) ((float*)(ws + O_LSE))[((size_t)(gi * 4 + g)) * TS + b * L + r * M + mq] = mx + __logf(den);
  __syncthreads();
  stage_kv(qkv + 3072 + head * 128, b, L, dil, r, m0, M, img, nullptr, ht);
  __syncthreads();
  f32x16 oa[4];
#pragma unroll
  for (int dt = 0; dt < 4; ++dt)
#pragma unroll
    for (int i = 0; i < 16; ++i) oa[dt][i] = 0.f;
  const int i16 = lane & 15, q4 = i16 >> 2, p4 = i16 & 3, blk = (lane >> 4) & 1;
#pragma unroll
  for (int kt = 0; kt < 5; ++kt)
#pragma unroll
    for (int s = 0; s < 2; ++s) {
      u32x4 pb; pb.x = pk2(sc[kt][8 * s + 0] * inv, sc[kt][8 * s + 1] * inv); pb.y = pk2(sc[kt][8 * s + 2] * inv, sc[kt][8 * s + 3] * inv);
      pb.z = pk2(sc[kt][8 * s + 4] * inv, sc[kt][8 * s + 5] * inv); pb.w = pk2(sc[kt][8 * s + 6] * inv, sc[kt][8 * s + 7] * inv);
      const bf16x8 bfr = __builtin_bit_cast(bf16x8, pb);
      const LAS unsigned char* vp = img + (32 * wq + 32 * kt + 16 * s + 4 * h + q4) * KROW + 2 * (16 * blk + 4 * p4);
#pragma unroll
      for (int dt = 0; dt < 4; ++dt) {
        const s16x4 lo = __builtin_amdgcn_ds_read_tr16_b64_v4i16((LAS s16x4*)(vp + 64 * dt));
        const s16x4 hi4 = __builtin_amdgcn_ds_read_tr16_b64_v4i16((LAS s16x4*)(vp + 64 * dt + 8 * KROW));
        const bf16x8 a = __builtin_shufflevector(lo, hi4, 0, 1, 2, 3, 4, 5, 6, 7);
        oa[dt] = __builtin_amdgcn_mfma_f32_32x32x16_bf16(a, bfr, oa[dt], 0, 0, 0);
      }
    }
  u16* o3 = (u16*)(ws + O_O3) + ((size_t)gi * TS + tokq) * 512 + g * 128;
#pragma unroll
  for (int dt = 0; dt < 4; ++dt)
#pragma unroll
    for (int g4 = 0; g4 < 4; ++g4) {
      u32x2 o; o.x = pk2(oa[dt][4 * g4], oa[dt][4 * g4 + 1]); o.y = pk2(oa[dt][4 * g4 + 2], oa[dt][4 * g4 + 3]);
      *(u32x2*)(o3 + 32 * dt + 8 * g4 + 4 * h) = o;
    }
  __syncthreads();
}

constexpr int ZBLK = 272;
constexpr int ZS_BYTES = 128 * ZBLK + 512;
constexpr int WIN_COPY = 544, WIN_BYTES = 8 * WIN_COPY;
constexpr int CONV_GRP = 4;
constexpr int CONV_ZERO_OFF = 2 * ZS_BYTES + 2 * 2 * CONV_GRP * WIN_BYTES;

struct Sc4Raw { u32x2 v; unsigned pr, nr; };
__device__ __forceinline__ Sc4Raw sc4_load(const u16* row_, int tok) {
  const GAS u16* row = (const GAS u16*)row_;
  Sc4Raw r; r.v = *(const GAS u32x2*)(row + (unsigned)tok);
  const int ip = tok > 0 ? tok - 1 : 0, in = tok + 4 < TS ? tok + 4 : TS - 1;
  r.pr = (unsigned)row[(unsigned)ip]; r.nr = (unsigned)row[(unsigned)in];
  return r;
}
__device__ __forceinline__ f32x4 sc4_apply(const Sc4Raw& r, int tok, int L, float w0, float w1, float w2, float bb) {
  const float c0 = lo16(r.v.x), c1 = hi16(r.v.x), c2 = lo16(r.v.y), c3 = hi16(r.v.y);
  const float pv = ((tok & (L - 1)) == 0) ? 0.f : bf2f(r.pr);
  const float nx = (((tok + 4) & (L - 1)) == 0) ? 0.f : bf2f(r.nr);
  f32x4 o; o[0] = w0 * pv + w1 * c0 + w2 * c1 + bb; o[1] = w0 * c0 + w1 * c1 + w2 * c2 + bb; o[2] = w0 * c1 + w1 * c2 + w2 * c3 + bb; o[3] = w0 * c2 + w1 * c3 + w2 * nx + bb;
  return o;
}
__device__ __forceinline__ f32x4 sc4(const u16* row_, int tok, int L, float w0, float w1, float w2, float bb) { const Sc4Raw r = sc4_load(row_, tok); return sc4_apply(r, tok, L, w0, w1, w2, bb); }

__device__ __forceinline__ void conv_item(const Params& P, int slice, int item, LAS unsigned char* lds) {
  unsigned char* ws = P.ws; LAUNDER_S(ws); int tid = threadIdx.x; LAUNDER_V(tid);
  const int wave = __builtin_amdgcn_readfirstlane(tid >> 6), lane = tid & 63, chh = wave >> 2, w4 = wave & 3, wm = w4 & 1, wn = (w4 >> 1) ^ chh  , ht = tid & 255, ln = lane & 31, h = lane >> 5;
  const int c = item * 2 + chh;
  const int L = slice < 4 ? 2048 : 16384, nb = slice < 4 ? 8 : 1, nblk = 128 / nb, nbsh = slice < 4 ? 3 : 0;
  const u16* hyT = (const u16*)(ws + O_HYT);
  LAS unsigned char* Zs = lds + chh * ZS_BYTES;
  LAS unsigned char* Wn = lds + 2 * ZS_BYTES + chh * 2 * CONV_GRP * WIN_BYTES;
  const float* wsh = P.in[I_WSH]; const float* bsh = P.in[I_BSH];
  if (tid < 64) *(LAS unsigned*)(lds + CONV_ZERO_OFF + 4 * tid) = 0u;
  {
    const u16* row = hyT + (size_t)c * TS; const float w0 = wsh[c], w1 = wsh[3072 + c], w2 = wsh[6144 + c], bb = bsh[c];
#pragma unroll
    for (int hh = 0; hh < 2; ++hh) {
      Sc4Raw zr[4][2];
#pragma unroll
      for (int i4 = 0; i4 < 4; ++i4) { const int tok = 8 * (ht + 256 * (4 * hh + i4)); zr[i4][0] = sc4_load(row, tok); zr[i4][1] = sc4_load(row, tok + 4); }
      __builtin_amdgcn_sched_barrier(0);
#pragma unroll
      for (int i4 = 0; i4 < 4; ++i4) {
        const int tok = 8 * (ht + 256 * (4 * hh + i4));
        const f32x4 a = sc4_apply(zr[i4][0], tok, L, w0, w1, w2, bb), bq = sc4_apply(zr[i4][1], tok + 4, L, w0, w1, w2, bb);
        const int Bk = tok >> 7, bs = Bk / nblk;
        u32x4 o; o.x = pk2(a[0], a[1]); o.y = pk2(a[2], a[3]); o.z = pk2(bq[0], bq[1]); o.w = pk2(bq[2], bq[3]);
        *(LAS u32x4*)(Zs + Bk * ZBLK + bs * 32 + 2 * (tok & 127)) = o;
      }
      __builtin_amdgcn_sched_barrier(0);
    }
  }
  const int nsteps = 2 * nblk - 1, dmin = -(nblk - 1);
  int aro[2];
#pragma unroll
  for (int mt = 0; mt < 2; ++mt) { const int i = 64 * wm + 32 * mt + ln; aro[mt] = (i & 7) * WIN_COPY + 2 * (128 + 8 * h - (i & ~7)); }
  const int wdo = (ht >> 5) * WIN_COPY + 4 * (ht & 31);

  for (int order = 0; order < 2; ++order) {
    const GAS u16* G = (const GAS u16*)(ws + (L == 2048 ? O_G2K : O_G16K)) + (size_t)(order * 1024 + c) * (size_t)(2 * L);
    f32x16 acc[2][2];
#pragma unroll
    for (int a = 0; a < 2; ++a)
#pragma unroll
      for (int b2 = 0; b2 < 2; ++b2)
#pragma unroll
        for (int i = 0; i < 16; ++i) acc[a][b2][i] = 0.f;
    unsigned wl[8];
    const int ub = L - 129 + 2 * (ht & 31) - (ht >> 5);
#define CONV_LOADWIN(dd) do { _Pragma("unroll") for (int q = 0; q < 4; ++q) { const int u = ub + 64 * q - 128 * (dd); \
      int i0 = u + (u > L - 1 ? 1 : 0), i1 = u + 1 + (u >= L - 1 ? 1 : 0); i0 = i0 < 0 ? 0 : (i0 > 2 * L - 1 ? 2 * L - 1 : i0); i1 = i1 < 0 ? 0 : (i1 > 2 * L - 1 ? 2 * L - 1 : i1); \
      wl[2 * q] = (unsigned)G[(unsigned)i0]; wl[2 * q + 1] = (unsigned)G[(unsigned)i1]; } } while (0)
#define CONV_STOREWIN(t) do { LAS unsigned char* wd_ = Wn + ((((t) >> 2) & 1) * CONV_GRP + ((t) & 3)) * WIN_BYTES + wdo; _Pragma("unroll") for (int q = 0; q < 8; ++q) LAUNDER_V(wl[q]); _Pragma("unroll") for (int q = 0; q < 4; ++q) \
      *(LAS unsigned*)(wd_ + 128 * q) = wl[2 * q] | (wl[2 * q + 1] << 16); } while (0)
#define CONV_ROT() do { } while (0)
    { unsigned w4[CONV_GRP][8];
#pragma unroll
      for (int t0 = 0; t0 < CONV_GRP; ++t0) { CONV_LOADWIN(dmin + t0);
#pragma unroll
        for (int q = 0; q < 8; ++q) w4[t0][q] = wl[q]; }
      __builtin_amdgcn_sched_barrier(0);
#pragma unroll
      for (int t0 = 0; t0 < CONV_GRP; ++t0) {
#pragma unroll
        for (int q = 0; q < 8; ++q) wl[q] = w4[t0][q];
        CONV_STOREWIN(t0); }
    }
    __syncthreads();
    const int q0 = 2 * wn, q1 = 2 * wn + 1;
    const int lo0 = ((32 * q0) >> nbsh) - (nblk - 1), hi0 = (32 * q0 + 31) >> nbsh, lo1 = ((32 * q1) >> nbsh) - (nblk - 1), hi1 = (32 * q1 + 31) >> nbsh;
    const int n0 = 32 * q0 + ln, n1 = 32 * q1 + ln;
    const int bk0 = n0 >> nbsh, bs0 = n0 & (nb - 1); (void)n1;
    const LAS unsigned char* zb0 = Zs + (bs0 * nblk) * ZBLK + bs0 * 32 + 16 * h;
#define bk1 (bk0 + (32 >> nbsh))
#define zb1 zb0
    bf16x8 fa[10], fb[8];
#define CONV_MFMA(a_, b_, c_) __builtin_amdgcn_mfma_f32_32x32x16_bf16((a_), (b_), (c_), 0, 0, 0)
#define CONV_WB(st) (Wn + ((((st) >> 2) & 1) * CONV_GRP + ((st) & 3)) * WIN_BYTES + aro[0])
#define CONV_BP(T, e) ((((bk##T) - (e)) >= 0 && ((bk##T) - (e)) < nblk) ? zb##T + ((bk##T) - (e)) * ZBLK : (const LAS unsigned char*)(lds + CONV_ZERO_OFF))
#define CONV_TILESTEP(TT, NBP, PF, NWB) do { \
      const LAS unsigned char* nbp_ = (NBP); const LAS unsigned char* nwb_ = (NWB); \
      __builtin_amdgcn_sched_barrier(0); __builtin_amdgcn_s_setprio(1); \
      _Pragma("unroll") for (int ks = 0; ks < 8; ++ks) { \
        acc[0][TT] = CONV_MFMA(fa[ks + 2], fb[ks], acc[0][TT]); acc[1][TT] = CONV_MFMA(fa[ks], fb[ks], acc[1][TT]); \
        fb[ks] = *(const LAS bf16x8*)(nbp_ + 32 * ks); \
        if (PF) fa[ks] = *(const LAS bf16x8*)(nwb_ + 32 * (ks - 2)); \
      } \
      if (PF) { fa[8] = *(const LAS bf16x8*)(nwb_ + 32 * 6); fa[9] = *(const LAS bf16x8*)(nwb_ + 32 * 7); } \
      _Pragma("unroll") for (int ks = 0; ks < 8; ++ks) { __builtin_amdgcn_sched_group_barrier(0x008, 2, 0); __builtin_amdgcn_sched_group_barrier(0x100, (PF) ? 2 : 1, 0); } \
      if (PF) __builtin_amdgcn_sched_group_barrier(0x100, 2, 0); \
      __builtin_amdgcn_sched_barrier(0); __builtin_amdgcn_s_setprio(0); \
    } while (0)
#define CONV_HEAD() const int step = d - dmin; if (step + CONV_GRP < nsteps) CONV_LOADWIN(d + CONV_GRP); __builtin_amdgcn_sched_barrier(0)
#define CONV_TAIL() if (step + CONV_GRP < nsteps) CONV_STOREWIN(step + CONV_GRP); if ((step & 1) == 1 || step + 1 == nsteps) __syncthreads()
#define CONV_TAILT() if (step + CONV_GRP < nsteps) CONV_STOREWIN(step + CONV_GRP); \
      if (step + 1 == nsteps) __syncthreads(); \
      else if ((step & 1) == 1) { asm volatile("s_waitcnt lgkmcnt(15)" ::: "memory"); __builtin_amdgcn_s_barrier(); asm volatile("" ::: "memory"); }
    for (int d = dmin; d < lo0; ++d) { CONV_HEAD(); CONV_TAIL(); }
    {
      const LAS unsigned char* wb = CONV_WB(lo0 - dmin); const LAS unsigned char* bp = CONV_BP(0, lo0);
#pragma unroll
      for (int k = 0; k < 10; ++k) fa[k] = *(const LAS bf16x8*)(wb + 32 * (k - 2));
#pragma unroll
      for (int ks = 0; ks < 8; ++ks) fb[ks] = *(const LAS bf16x8*)(bp + 32 * ks);
    }
    for (int d = lo0; d < lo1; ++d) { CONV_HEAD(); CONV_TILESTEP(0, CONV_BP(0, d + 1), 1, CONV_WB(step + 1)); CONV_TAILT(); }
    for (int d = lo1; d <= hi0; ++d) { CONV_HEAD(); CONV_TILESTEP(0, CONV_BP(1, d), 0, Wn);
      CONV_TILESTEP(1, (d + 1 <= hi0) ? CONV_BP(0, d + 1) : CONV_BP(1, d + 1), 1, CONV_WB(step + 1)); CONV_TAILT(); }
    for (int d = hi0 + 1; d <= hi1; ++d) { CONV_HEAD(); CONV_TILESTEP(1, CONV_BP(1, d + 1), 1, CONV_WB(step + 1)); CONV_TAILT(); }
    for (int d = hi1 + 1; d < nblk; ++d) { CONV_HEAD(); CONV_TAIL(); }
#undef bk1
#undef zb1
#undef CONV_MFMA
#undef CONV_WB
#undef CONV_BP
#undef CONV_TILESTEP
#undef CONV_HEAD
#undef CONV_TAIL
#undef CONV_TAILT

#undef CONV_ROT
#undef CONV_LOADWIN
#undef CONV_STOREWIN
    {
      const int gc = 1024 * (order + 1) + c; const u16* grow = hyT + (size_t)gc * TS;
      const float w0 = wsh[gc], w1 = wsh[3072 + gc], w2 = wsh[6144 + gc], bb = bsh[gc], skip = P.in[I_FSK][order * 1024 + c];
      GAS u16* zt = (GAS u16*)(ws + O_ZT) + (size_t)c * TS;
      int te = threadIdx.x; LAUNDER_V(te); const int ln = te & 31, h = (te >> 5) & 1;
#pragma unroll
      for (int nt = 0; nt < 2; ++nt) {
        const int n = 32 * (2 * wn + nt) + ln, bk = n >> nbsh, bs = n & (nb - 1), Bo = bs * nblk + bk;
        Sc4Raw gr[2][4];
#pragma unroll
        for (int mt = 0; mt < 2; ++mt)
#pragma unroll
          for (int g4 = 0; g4 < 4; ++g4) gr[mt][g4] = sc4_load(grow, Bo * 128 + 64 * wm + 32 * mt + 8 * g4 + 4 * h);
        __builtin_amdgcn_sched_barrier(0);
#pragma unroll
        for (int mt = 0; mt < 2; ++mt)
#pragma unroll
          for (int g4 = 0; g4 < 4; ++g4) {
            const int s0 = 64 * wm + 32 * mt + 8 * g4 + 4 * h, tok = Bo * 128 + s0;
            LAS u32x2* zp = (LAS u32x2*)(Zs + Bo * ZBLK + bs * 32 + 2 * s0);
            const u32x2 zv = *zp; const f32x4 gt = sc4_apply(gr[mt][g4], tok, L, w0, w1, w2, bb);
            const float y0 = gt[0] * (acc[mt][nt][4 * g4 + 0] + skip * lo16(zv.x)), y1 = gt[1] * (acc[mt][nt][4 * g4 + 1] + skip * hi16(zv.x));
            const float y2 = gt[2] * (acc[mt][nt][4 * g4 + 2] + skip * lo16(zv.y)), y3 = gt[3] * (acc[mt][nt][4 * g4 + 3] + skip * hi16(zv.y));
            u32x2 o; o.x = pk2(y0, y1); o.y = pk2(y2, y3);
            if (order == 0) *zp = o; else *(GAS u32x2*)(zt + (unsigned)tok) = o;
          }
        __builtin_amdgcn_sched_barrier(0);
      }
    }
    __syncthreads();
  }
}

__device__ __forceinline__ void phase_combine(const Params& P, int slice, LAS unsigned char* lds) {
  unsigned char* ws = P.ws; LAUNDER_S(ws); int tid = threadIdx.x; LAUNDER_V(tid); const int bid = blockIdx.x, G = gridDim.x;
  const GAS float* lse = (const GAS float*)(ws + O_LSE); const GAS u16* o3 = (const GAS u16*)(ws + O_O3); GAS u16* att = (GAS u16*)(ws + O_ATT);
  const int Lc = slice < 4 ? 2048 : 16384;
  for (int idx0 = bid * 512 + tid; idx0 < TS * 64; idx0 += 2 * G * 512) {
    float l[2][3]; u32x4 ov[2][3]; int tokv[2], chv[2]; bool ok[2];
#pragma unroll
    for (int r = 0; r < 2; ++r) {
      int idx = idx0 + r * G * 512; ok[r] = idx < TS * 64; idx = ok[r] ? idx : idx0;
      const int tok = idx >> 6, ch = idx & 63, g = ch >> 4; tokv[r] = tok; chv[r] = ch;
      const int tl = tok & (Lc - 1), tb = tok - tl;
      l[r][0] = lse[(size_t)(0 + g) * TS + tok];
      l[r][1] = lse[(size_t)(4 + g) * TS + tb + (tl & 3) * (Lc >> 2) + (tl >> 2)];
      l[r][2] = lse[(size_t)(8 + g) * TS + tb + (tl & 15) * (Lc >> 4) + (tl >> 4)];
#pragma unroll
      for (int gi = 0; gi < 3; ++gi) ov[r][gi] = *(const GAS u32x4*)(o3 + ((size_t)gi * TS + tok) * 512 + ch * 8);
    }
    __builtin_amdgcn_sched_barrier(0);
#pragma unroll
    for (int r = 0; r < 2; ++r) {
      const float m = fmaxf(l[r][0], fmaxf(l[r][1], l[r][2])); float e0 = __expf(l[r][0] - m), e1 = __expf(l[r][1] - m), e2 = __expf(l[r][2] - m);
      const float inv = __builtin_amdgcn_rcpf(e0 + e1 + e2); e0 *= inv; e1 *= inv; e2 *= inv;
      const u32x4 a = ov[r][0], b = ov[r][1], cc = ov[r][2];
      u32x4 o;
      o.x = pk2(e0 * lo16(a.x) + e1 * lo16(b.x) + e2 * lo16(cc.x), e0 * hi16(a.x) + e1 * hi16(b.x) + e2 * hi16(cc.x));
      o.y = pk2(e0 * lo16(a.y) + e1 * lo16(b.y) + e2 * lo16(cc.y), e0 * hi16(a.y) + e1 * hi16(b.y) + e2 * hi16(cc.y));
      o.z = pk2(e0 * lo16(a.z) + e1 * lo16(b.z) + e2 * lo16(cc.z), e0 * hi16(a.z) + e1 * hi16(b.z) + e2 * hi16(cc.z));
      o.w = pk2(e0 * lo16(a.w) + e1 * lo16(b.w) + e2 * lo16(cc.w), e0 * hi16(a.w) + e1 * hi16(b.w) + e2 * hi16(cc.w));
      if (ok[r]) *(GAS u32x4*)(att + (size_t)tokv[r] * 512 + chv[r] * 8) = o;
    }
    __builtin_amdgcn_sched_barrier(0);
  }
  const GAS u16* zt = (const GAS u16*)(ws + O_ZT); GAS u16* zr = (GAS u16*)(ws + O_ZR); LAS u16* tl = (LAS u16*)lds;
  for (int tile0 = bid; tile0 < 16 * 256; tile0 += 8 * G) {
    u32x4 tv[8];
#pragma unroll
    for (int kk = 0; kk < 8; ++kk) { int tile = tile0 + kk * G; tile = tile < 16 * 256 ? tile : tile0;
      const int cb = tile >> 8, tb = tile & 255; tv[kk] = *(const GAS u32x4*)(zt + (size_t)(cb * 64 + (tid >> 3)) * TS + tb * 64 + 8 * (tid & 7)); }
    __builtin_amdgcn_sched_barrier(0);
#pragma unroll
    for (int kk = 0; kk < 8; ++kk) {
      const int tile = tile0 + kk * G;
      if (tile < 16 * 256) {
        const int cb = tile >> 8, tb = tile & 255, c0 = cb * 64, t0 = tb * 64;
        { const int cc = tid >> 3, k = tid & 7; LAS unsigned* d = (LAS unsigned*)(tl + cc * 72 + 8 * k); d[0] = tv[kk].x; d[1] = tv[kk].y; d[2] = tv[kk].z; d[3] = tv[kk].w; }
        __syncthreads();
        { const int tt = tid >> 3, k = tid & 7; unsigned e[8];
#pragma unroll
          for (int j = 0; j < 8; ++j) e[j] = tl[(8 * k + j) * 72 + tt];
          u32x4 o; o.x = e[0] | (e[1] << 16); o.y = e[2] | (e[3] << 16); o.z = e[4] | (e[5] << 16); o.w = e[6] | (e[7] << 16);
          *(GAS u32x4*)(zr + (size_t)(t0 + tt) * 1024 + c0 + 8 * k) = o; }
        __syncthreads();
      }
    }
  }
}

constexpr int NPHASE = 2 + 3 * NSL + 2 + (NSL + 1);
#ifndef PHM
#define PHM 0xffff
#endif
__global__ void __launch_bounds__(512) fwd_megakernel(Params P) {
  extern __shared__ __attribute__((aligned(16))) unsigned char shm[];
  LAS unsigned char* lds = (LAS unsigned char*)shm;
  cg::grid_group grid = cg::this_grid();
  if (blockIdx.x == 0 && threadIdx.x == 0) __hip_atomic_store((unsigned*)(P.ws + O_CTR), 0u, __ATOMIC_RELAXED, __HIP_MEMORY_SCOPE_AGENT);
  for (int ph = P.ph_lo; ph < P.ph_hi; ++ph) {
    unsigned char* ws = P.ws; LAUNDER_S(ws);
    if (ph == 0) { if (PHM & 1) phase_prep(P, lds); }
    else {
      const int q = ph - 2, s = q / 3, k = q % 3;
      if (ph >= 2 && ph < 2 + 3 * NSL && k == 0) {
        const int NATT = 768, NCONV = 512;
        for (int it = blockIdx.x; it < NATT + NCONV; it += gridDim.x) { if (it < NATT) attn_item(P, s, it, lds); else conv_item(P, s, it - NATT, lds); }
      } else if (ph >= 2 && ph < 2 + 3 * NSL && k == 1) {
        phase_combine(P, s, lds);
      } else {
        const int PH_OUT = 2 + 3 * NSL, c = ph - (PH_OUT + 2);
        int ng;
        if (ph == 1) ng = 2; else if (ph < PH_OUT) ng = (s < NSL - 1) ? 3 : 2; else if (ph == PH_OUT) ng = 1; else if (ph == PH_OUT + 1) ng = 0; else ng = (c == 0 || c == NSL) ? 1 : 2;
        if (ph == PH_OUT + 1) {
          const GAS float* sp = (const GAS float*)(ws + O_SSQ2); GAS float* r2 = (GAS float*)(ws + O_RSTD2);
          int t3 = threadIdx.x; LAUNDER_V(t3);
          for (int row = blockIdx.x * 512 + t3; row < TALL; row += gridDim.x * 512) {
            float pq[16];
#pragma unroll
            for (int q2 = 0; q2 < 16; ++q2) pq[q2] = sp[(size_t)q2 * TALL + row];
            float sst = 0.f;
#pragma unroll
            for (int q2 = 0; q2 < 16; ++q2) sst += pq[q2];
            r2[row] = rsqrtf(sst * (1.0f / 1024.0f) + 1e-6f); }
        }
#pragma nounroll
        for (int gi = 0; gi < ng; ++gi) {
          const u16* A; const u16* Bt; int M = TS, N = 1024, K = 1024, mode, slo = 0, shi = 0, sl = 0;
          if (ph == 1 && gi == 0) { A = (const u16*)(ws + O_H3); Bt = (const u16*)(ws + O_W4); M = NPOS; N = 4096; K = 256; mode = EM_FILT; slo = 0; shi = 1 << 30; }
          else if (ph == 1 || (ph < PH_OUT && gi == 2)) { sl = (ph == 1) ? 0 : s + 1; A = (const u16*)(ws + O_XB) + (size_t)sl * TS * DM; Bt = (const u16*)(ws + O_WIN); N = INW; mode = EM_INPROJ; slo = 18; shi = 30; }
          else if (ph < PH_OUT && gi == 0) { sl = s; A = (const u16*)(ws + O_ATT); Bt = (const u16*)(ws + O_WAB); K = 512; mode = EM_AB; }
          else if (ph < PH_OUT) { sl = s; A = (const u16*)(ws + O_ZR); Bt = (const u16*)(ws + O_WHB); mode = EM_HBR; }
          else if (ph == PH_OUT) { A = (const u16*)(ws + O_MG); Bt = (const u16*)(ws + O_WOUT); M = TALL; mode = EM_OUT; }
          else if ((c > 0 && gi == 0) || c == NSL) { sl = c - 1; A = (const u16*)(ws + O_HB + (size_t)(sl & 1) * HB_BYTES); Bt = (const u16*)(ws + O_WF2); K = DFF; mode = EM_FF2; }
          else { sl = c; A = (const u16*)(ws + O_X2B) + (size_t)sl * TS * DM; Bt = (const u16*)(ws + O_WF1); N = DFF; mode = EM_FF1; }
          run_gemm(P, lds, A, Bt, M, N, K, mode, sl, slo, shi);
        }
      }
    }
    if (ph + 1 < P.ph_hi) {
      asm volatile("s_waitcnt vmcnt(0) lgkmcnt(0)" ::: "memory");
      __syncthreads();
      if (ph == P.ph_lo) {
        if (threadIdx.x < 64) { __builtin_amdgcn_fence(__ATOMIC_RELEASE, "agent"); asm volatile("s_waitcnt vmcnt(0)" ::: "memory"); }
        __syncthreads();
        grid.sync();
        __builtin_amdgcn_fence(__ATOMIC_ACQUIRE, "agent");
        asm volatile("s_waitcnt vmcnt(0)" ::: "memory");
      } else {
        if (threadIdx.x == 0) {
          unsigned* ctr = (unsigned*)(ws + O_CTR);
          const unsigned target = (unsigned)(ph - P.ph_lo) * gridDim.x;
          __builtin_amdgcn_fence(__ATOMIC_RELEASE, "agent");
          asm volatile("s_waitcnt vmcnt(0)" ::: "memory");
          __hip_atomic_fetch_add(ctr, 1u, __ATOMIC_RELAXED, __HIP_MEMORY_SCOPE_AGENT);
          while (__hip_atomic_load(ctr, __ATOMIC_RELAXED, __HIP_MEMORY_SCOPE_AGENT) < target) __builtin_amdgcn_s_sleep(2);
          __builtin_amdgcn_fence(__ATOMIC_ACQUIRE, "agent");
          asm volatile("s_waitcnt vmcnt(0)" ::: "memory");
        }
        __syncthreads();
      }
    }
  }
}

extern "C" void kernel_launch(void* const* d_in, const int* in_sizes, int n_in, void* d_out, int out_size, void* d_ws, size_t ws_size, hipStream_t stream) {
  static int grid_blocks = 0;
  if (!grid_blocks) {
    if (n_in != 24 || ws_size < WS_END) { fprintf(stderr, "kernel_launch: unexpected n_in %d or ws_size %zu (< %zu)\n", n_in, ws_size, (size_t)WS_END); grid_blocks = -1; return; }
    int dev = 0, cus = 0, per_cu = 0;
    hipGetDevice(&dev);
    hipDeviceGetAttribute(&cus, hipDeviceAttributeMultiprocessorCount, dev);
    if (hipFuncSetAttribute((const void*)fwd_megakernel, hipFuncAttributeMaxDynamicSharedMemorySize, LDS_BYTES) != hipSuccess) { fprintf(stderr, "hipFuncSetAttribute failed\n"); grid_blocks = -1; return; }
    hipOccupancyMaxActiveBlocksPerMultiprocessor(&per_cu, (const void*)fwd_megakernel, 512, LDS_BYTES);
    if (per_cu < 1) per_cu = 1;
    grid_blocks = cus * per_cu;
  }
  if (grid_blocks < 0) return;
  Params p{};
  for (int i = 0; i < 24; ++i) p.in[i] = (const float*)d_in[i];
  p.out = (float*)d_out; p.ws = (unsigned char*)d_ws;
#if N_LAUNCH_MODE == 1
  p.ph_lo = 0; p.ph_hi = NPHASE;
  void* args[] = {&p};
  hipError_t e = hipLaunchCooperativeKernel((const void*)fwd_megakernel, dim3(grid_blocks), dim3(512), args, LDS_BYTES, stream);
  if (e != hipSuccess) fprintf(stderr, "cooperative launch failed: %s (grid %d)\n", hipGetErrorString(e), grid_blocks);
#else
  for (int ph = 0; ph < NPHASE; ++ph) {
    p.ph_lo = ph; p.ph_hi = ph + 1;
    hipLaunchKernelGGL(fwd_megakernel, dim3(grid_blocks), dim3(512), LDS_BYTES, stream, p);
  }
#endif
}
```

```cpp
#include <hip/hip_runtime.h>
#include <hip/hip_cooperative_groups.h>
#include <cstdio>
namespace cg = cooperative_groups;

#define LAS __attribute__((address_space(3)))
#define GAS __attribute__((address_space(1)))
typedef unsigned short u16;
typedef short bf16x8 __attribute__((ext_vector_type(8)));
typedef short s16x4 __attribute__((ext_vector_type(4)));
typedef float f32x4 __attribute__((ext_vector_type(4)));
typedef float f32x16 __attribute__((ext_vector_type(16)));
typedef unsigned u32x4 __attribute__((ext_vector_type(4)));
typedef unsigned u32x2 __attribute__((ext_vector_type(2)));

#ifndef N_LAUNCH_MODE
#define N_LAUNCH_MODE 1
#endif

constexpr int DM = 1024, TALL = 81920, TS = 16384, NSL = 5, INW = 9728, DFF = 4096;
constexpr int NPOS = 2048 + 16384;
constexpr int LDS_BYTES = 147456;

constexpr size_t al256(size_t x) { return (x + 255) & ~(size_t)255; }
constexpr size_t O_WIN = 0;
constexpr size_t O_WAB = O_WIN + (size_t)INW * DM * 2;
constexpr size_t O_WHB = O_WAB + (size_t)DM * 512 * 2;
constexpr size_t O_WOUT = O_WHB + (size_t)DM * DM * 2;
constexpr size_t O_WF1 = O_WOUT + (size_t)DM * DM * 2;
constexpr size_t O_WF2 = O_WF1 + (size_t)DFF * DM * 2;
constexpr size_t O_W4 = O_WF2 + (size_t)DFF * DM * 2;
constexpr size_t O_H3 = O_W4 + (size_t)4096 * 256 * 2;
constexpr size_t O_G2K = O_H3 + (size_t)NPOS * 256 * 2;
constexpr size_t O_G16K = O_G2K + (size_t)2 * 1024 * 4096 * 2;
constexpr size_t O_XB = O_G16K + (size_t)2 * 1024 * 32768 * 2;
constexpr size_t O_RSTD1 = O_XB + (size_t)TALL * DM * 2;
constexpr size_t O_SSQ2 = O_RSTD1 + (size_t)TALL * 4;
constexpr size_t O_BIAS = O_SSQ2 + (size_t)TALL * 64;
constexpr size_t O_QKV = O_BIAS + 8192;
constexpr size_t O_HYT = O_QKV + (size_t)TS * 4608 * 2;
constexpr size_t O_SG = O_HYT + (size_t)3072 * TS * 2;
constexpr size_t SG_BYTES = (size_t)TS * 2048 * 2;
constexpr size_t O_O3 = O_SG + 2 * SG_BYTES;
constexpr size_t O_LSE = O_O3 + (size_t)3 * TS * 512 * 2;
constexpr size_t O_ATT = O_LSE + (size_t)3 * TS * 4 * 4;
constexpr size_t O_ZT = O_ATT + (size_t)TS * 512 * 2;
constexpr size_t O_ZR = O_ZT + (size_t)1024 * TS * 2;
constexpr size_t O_MG = O_ZR + (size_t)TS * 1024 * 2;
constexpr size_t O_CTR = O_MG + (size_t)TALL * 1024 * 2;
constexpr size_t O_RSTD2 = O_CTR + 256;
constexpr size_t WS_END = O_RSTD2 + (size_t)TALL * 4;
static_assert(WS_END <= (size_t)1073741824, "workspace budget");
constexpr size_t O_X2B = O_XB;
constexpr size_t HB_BYTES = (size_t)TS * DFF * 2;
constexpr size_t O_HB = O_QKV;
static_assert(O_HB + 2 * HB_BYTES <= O_MG, "hidden buffers alias only per-slice mixer buffers");

struct Params {
  const float* in[24];
  float* out;
  unsigned char* ws;
  int ph_lo, ph_hi;
};
enum { I_XP = 0, I_XS, I_RELB, I_GMIX, I_WIN, I_GQ, I_GK, I_WAB, I_WSH, I_BSH, I_FW1, I_FB1, I_FW2, I_FB2, I_FW3, I_FB3, I_FW4, I_FFR, I_FSK, I_WHB, I_WOUT, I_GMLP, I_WF1, I_WF2 };

#define LAUNDER_V(x) asm volatile("" : "+v"(x))
#define LAUNDER_S(x) asm volatile("" : "+s"(x))
__device__ __forceinline__ float bf2f(unsigned v) { return __uint_as_float(v << 16); }
typedef __bf16 bf16x2_t __attribute__((ext_vector_type(2)));
typedef float f32x2_t __attribute__((ext_vector_type(2)));
__device__ __forceinline__ unsigned pk2(float lo, float hi) { const f32x2_t f = {lo, hi}; const bf16x2_t b = __builtin_convertvector(f, bf16x2_t); return __builtin_bit_cast(unsigned, b); }
__device__ __forceinline__ float lo16(unsigned v) { return __uint_as_float(v << 16); }
__device__ __forceinline__ float hi16(unsigned v) { return __uint_as_float(v & 0xffff0000u); }

namespace pg8 {
constexpr int BM = 256, BK = 64, HALF = 128, HTB = HALF * BK * 2, STAGE_BYTES = 8 * HTB, NXCD = 8, WGM = 8;
__device__ __forceinline__ int lds_byte(int r, int c) { const int st = (r >> 4) * 2 + (c >> 5), rr = r & 15, cc = c & 31, ob = rr * 64 + cc * 2; return st * 1024 + (ob ^ (((ob >> 9) & 1) << 5)); }
__device__ __forceinline__ void stage_rc(int b, int& R, int& C) { const int st = b / 1024, sb = b % 1024, swz = sb ^ (((sb >> 9) & 1) << 5); R = (st >> 1) * 16 + swz / 64; C = (st & 1) * 32 + (swz % 64) / 2; }
__device__ __forceinline__ int perm32(int rho) { const int n = rho >> 4, i = rho & 15; return 8 * (i >> 2) + 4 * n + (i & 3); }
struct Unit { int pm, pn, swap; };
struct Gemm { const u16* A; const u16* Bt; int M, N, K; };
struct StaticOrder {
  int nM, nN, nwg, G, c, slo, shi;
  __device__ void init(int M, int N, int G_, int c_, int slo_, int shi_) { nM = M / BM; nN = N / BM; nwg = nM * nN; G = G_; c = c_; slo = slo_; shi = shi_; }
  __device__ bool next(int i, Unit& u) const {
    const long L = (long)i * G + c; if (L >= nwg) return false;
    int wgid = (int)L; { const int q = nwg / NXCD, r = nwg % NXCD, xcd = wgid % NXCD, off = wgid / NXCD; wgid = (xcd < r ? xcd * (q + 1) : r * (q + 1) + (xcd - r) * q) + off; }
    const int nig = WGM * nN, gid = wgid / nig, fm = gid * WGM, gsz = (nM - fm) < WGM ? (nM - fm) : WGM;
    u.pm = fm + ((wgid % nig) % gsz); u.pn = (wgid % nig) / gsz; u.swap = (u.pn >= slo && u.pn < shi) ? 1 : 0; return true;
  }
};

template <class Epi>
__device__ __forceinline__ void gemm_phase(LAS unsigned char* lds, const Gemm g, const StaticOrder& S, const Epi& E) {
  int tid = threadIdx.x; LAUNDER_V(tid);
  const int wid = __builtin_amdgcn_readfirstlane(tid >> 6), lane = tid & 63, wr = wid >> 2, wc = wid & 3, fr = lane & 15, fq = lane >> 4;
  const int K = g.K, nt = K / BK;
  unsigned voffA[2], voffB[2];
#pragma unroll
  for (int i = 0; i < 2; ++i) { int R, C; stage_rc(tid * 16 + i * 8192, R, C); const int Rb = (R & ~31) + perm32(R & 31);
    voffA[i] = (unsigned)(R * K + C) * 2u; voffB[i] = (unsigned)(Rb * K + C) * 2u; }
  const size_t kstep = (size_t)(BK * 2);
  const size_t hstep = (size_t)HALF * K * 2;
  const size_t tstep = 2 * hstep;
  const unsigned ldsw = (unsigned)wid * 1024u;
  const int aoff = lds_byte(wr * 64 + fr, fq * 8), boff = lds_byte(wc * 32 + fr, fq * 8);
#define PG8_SA(b, h) (((b) * 2 + (h)) * HTB)
#define PG8_SB(b, h) ((4 + (b) * 2 + (h)) * HTB)
#define PG8_STAGE(bufoff, gbase, voff) do { _Pragma("unroll") for (int _i = 0; _i < 2; ++_i) \
    __builtin_amdgcn_global_load_lds((const unsigned*)((const char*)(gbase) + (voff)[_i]), (LAS unsigned*)(lds + (bufoff) + ldsw + _i * 8192), 16, 0, 0); } while (0)
#define PG8_LDA(dst, b, h) do { _Pragma("unroll") for (int m = 0; m < 4; ++m) _Pragma("unroll") for (int k = 0; k < 2; ++k) dst[m][k] = *(const LAS bf16x8*)(lds + PG8_SA(b, h) + aoff + m * 2048 + k * 1024); } while (0)
#define PG8_LDB(dst, b, h) do { _Pragma("unroll") for (int n = 0; n < 2; ++n) _Pragma("unroll") for (int k = 0; k < 2; ++k) dst[n][k] = *(const LAS bf16x8*)(lds + PG8_SB(b, h) + boff + n * 2048 + k * 1024); } while (0)
#define PG8_MMA(ai, bj, At, Bt) do { __builtin_amdgcn_s_setprio(1); _Pragma("unroll") for (int m = 0; m < 4; ++m) _Pragma("unroll") for (int n = 0; n < 2; ++n) _Pragma("unroll") for (int k = 0; k < 2; ++k) \
    acc[ai][bj][m][n] = __builtin_amdgcn_mfma_f32_16x16x32_bf16(Bt[n][k], At[m][k], acc[ai][bj][m][n], 0, 0, 0); __builtin_amdgcn_s_setprio(0); } while (0)
#define PG8_WAIT_V(n) asm volatile("s_waitcnt vmcnt(" #n ")" ::: "memory")
#define PG8_WAIT_L(n) asm volatile("s_waitcnt lgkmcnt(" #n ")" ::: "memory")
#define PG8_BAR __builtin_amdgcn_s_barrier()
#define PG8_SCHED __builtin_amdgcn_sched_barrier(0)
  Unit cur, nxt; int ui = 0;
  if (!S.next(0, cur)) return;
  f32x4 acc[2][2][4][2];
#pragma unroll
  for (int a = 0; a < 2; ++a)
#pragma unroll
    for (int b = 0; b < 2; ++b)
#pragma unroll
      for (int m = 0; m < 4; ++m)
#pragma unroll
        for (int n = 0; n < 2; ++n) acc[a][b][m][n] = (f32x4){0.f, 0.f, 0.f, 0.f};
  bf16x8 At[4][2], B0[2][2], B1[2][2];
  const char* pAm = (const char*)g.A + (size_t)cur.pm * tstep; const char* pBn = (const char*)g.Bt + (size_t)cur.pn * tstep;
  const char* cA = cur.swap ? pBn : pAm; const char* cB = cur.swap ? pAm : pBn;
  PG8_STAGE(PG8_SB(0, 0), cB, voffB); PG8_STAGE(PG8_SA(0, 0), cA, voffA); PG8_STAGE(PG8_SB(0, 1), cB + hstep, voffB); PG8_STAGE(PG8_SA(0, 1), cA + hstep, voffA);
  if (wr == 1) PG8_BAR;
  PG8_WAIT_V(4); PG8_BAR;
  PG8_STAGE(PG8_SB(1, 0), cB + kstep, voffB); PG8_STAGE(PG8_SA(1, 0), cA + kstep, voffA); PG8_STAGE(PG8_SB(1, 1), cB + hstep + kstep, voffB);
  PG8_WAIT_V(6); PG8_BAR;
  for (;;) {
    const bool has_next = S.next(ui + 1, nxt);
    const char* nA = cA; const char* nB = cB;
    if (has_next) { const char* qa = (const char*)g.A + (size_t)nxt.pm * tstep; const char* qb = (const char*)g.Bt + (size_t)nxt.pn * tstep; nA = nxt.swap ? qb : qa; nB = nxt.swap ? qa : qb; }
    for (int t = 0; t < nt; t += 2) {
      const bool last = (t == nt - 2);
      const char* a1 = cA + (size_t)(t + 1) * kstep;
      const char* a2 = last ? nA : cA + (size_t)(t + 2) * kstep; const char* b2 = last ? nB : cB + (size_t)(t + 2) * kstep;
      const char* a3 = a2 + kstep; const char* b3 = b2 + kstep;
      PG8_LDB(B0, 0, 0); PG8_SCHED; PG8_LDA(At, 0, 0); PG8_STAGE(PG8_SA(1, 1), a1 + hstep, voffA);
      PG8_WAIT_L(8); PG8_BAR; PG8_WAIT_L(0); PG8_MMA(0, 0, At, B0); PG8_BAR; PG8_SCHED;
      PG8_LDB(B1, 0, 1); PG8_STAGE(PG8_SB(0, 0), b2, voffB);
      PG8_BAR; PG8_WAIT_L(0); PG8_MMA(0, 1, At, B1); PG8_BAR;
      PG8_LDA(At, 0, 1); PG8_STAGE(PG8_SA(0, 0), a2, voffA);
      PG8_BAR; PG8_WAIT_L(0); PG8_MMA(1, 0, At, B0); PG8_BAR; PG8_SCHED;
      PG8_STAGE(PG8_SB(0, 1), b2 + hstep, voffB);
      PG8_WAIT_V(6); PG8_BAR; PG8_MMA(1, 1, At, B1); PG8_BAR;
      PG8_LDB(B0, 1, 0); PG8_SCHED; PG8_LDA(At, 1, 0); PG8_STAGE(PG8_SA(0, 1), a2 + hstep, voffA);
      PG8_WAIT_L(8); PG8_BAR; PG8_WAIT_L(0); PG8_MMA(0, 0, At, B0); PG8_BAR; PG8_SCHED;
      PG8_LDB(B1, 1, 1); PG8_STAGE(PG8_SB(1, 0), b3, voffB);
      PG8_BAR; PG8_WAIT_L(0); PG8_MMA(0, 1, At, B1); PG8_BAR;
      PG8_LDA(At, 1, 1); PG8_STAGE(PG8_SA(1, 0), a3, voffA);
      PG8_BAR; PG8_WAIT_L(0); PG8_MMA(1, 0, At, B0); PG8_BAR; PG8_SCHED;
      PG8_STAGE(PG8_SB(1, 1), b3 + hstep, voffB);
      PG8_WAIT_V(6); PG8_BAR; PG8_MMA(1, 1, At, B1); PG8_BAR;
    }
    E(acc, cur, wr, wc, fr, fq);
    if (!has_next) break;
#pragma unroll
    for (int a = 0; a < 2; ++a)
#pragma unroll
      for (int b = 0; b < 2; ++b)
#pragma unroll
        for (int m = 0; m < 4; ++m)
#pragma unroll
          for (int n = 0; n < 2; ++n) acc[a][b][m][n] = (f32x4){0.f, 0.f, 0.f, 0.f};
    cur = nxt; cA = nA; cB = nB; ++ui;
  }
  PG8_WAIT_V(0);
  if (wr == 0) PG8_BAR;
  PG8_BAR;
#undef PG8_SA
#undef PG8_SB
#undef PG8_STAGE
#undef PG8_LDA
#undef PG8_LDB
#undef PG8_MMA
#undef PG8_WAIT_V
#undef PG8_WAIT_L
#undef PG8_BAR
#undef PG8_SCHED
}
}

enum { EM_FILT = 0, EM_INPROJ, EM_AB, EM_HBR, EM_OUT, EM_FF1, EM_FF2 };
struct Epi {
  int mode, slice; const Params* P; unsigned char* wsl;
  __device__ __forceinline__ void operator()(const f32x4 (&acc)[2][2][4][2], const pg8::Unit& u, int wr, int wc, int fr, int fq) const {
    unsigned char* ws = wsl;
    const int prow = u.swap ? u.pn : u.pm, pcol = u.swap ? u.pm : u.pn;
    const int row0 = prow * 256 + wr * 64 + fr, col0 = pcol * 256 + wc * 32 + 8 * fq;
    if (mode == EM_FILT) {
      const float dmin = 3.0701134573253945f, dmax = 15.350567286626973f;
#pragma unroll
      for (int bj = 0; bj < 2; ++bj) {
        const int pr = col0 + bj * 128; const int L = pr < 2048 ? 2048 : 16384; const int p0 = pr < 2048 ? pr : pr - 2048;
        u16* G = (u16*)(ws + (L == 2048 ? O_G2K : O_G16K));
        const float tinv = 1.0f / (float)(L - 1);
#pragma unroll
        for (int ai = 0; ai < 2; ++ai)
#pragma unroll
          for (int m = 0; m < 4; ++m) {
            const int fc = row0 + ai * 128 + m * 16; const int order = fc >> 11, dir = (fc >> 10) & 1, c = fc & 1023;
            const float dl = dmin + (dmax - dmin) * ((float)c * (1.0f / 1023.0f));
            float v[8]; float dk = __expf(-(float)p0 * tinv * dl); const float dstep = __expf(-tinv * dl);
#pragma unroll
            for (int e = 0; e < 8; ++e) { v[e] = acc[ai][bj][m][e >> 2][e & 3] * dk; dk *= dstep; }
            u16* base = G + (size_t)(order * 1024 + c) * (size_t)(2 * L);
            u32x4 o;
            if (dir == 0) { o.x = pk2(v[7], v[6]); o.y = pk2(v[5], v[4]); o.z = pk2(v[3], v[2]); o.w = pk2(v[1], v[0]); *(u32x4*)(base + (L - 8 - p0)) = o; }
            else { o.x = pk2(v[0], v[1]); o.y = pk2(v[2], v[3]); o.z = pk2(v[4], v[5]); o.w = pk2(v[6], v[7]); *(u32x4*)(base + (L + p0)) = o; }
          }
      }
    } else if (mode == EM_INPROJ) {
      const float* rstd1 = (const float*)(ws + O_RSTD1) + (size_t)slice * TS;
      if (u.swap) {
        u16* hyT = (u16*)(ws + O_HYT);
        f32x4 rr[2][2];
#pragma unroll
        for (int bj = 0; bj < 2; ++bj) { rr[bj][0] = *(const f32x4*)(rstd1 + col0 + bj * 128); rr[bj][1] = *(const f32x4*)(rstd1 + col0 + bj * 128 + 4); }
        __builtin_amdgcn_sched_barrier(0);
#pragma unroll
        for (int bj = 0; bj < 2; ++bj) {
          const int tok0 = col0 + bj * 128;
#pragma unroll
          for (int ai = 0; ai < 2; ++ai)
#pragma unroll
            for (int m = 0; m < 4; ++m) {
              const int ch = row0 + ai * 128 + m * 16 - 4608;
              const f32x4 a = acc[ai][bj][m][0] * rr[bj][0], b = acc[ai][bj][m][1] * rr[bj][1];
              u32x4 o; o.x = pk2(a[0], a[1]); o.y = pk2(a[2], a[3]); o.z = pk2(b[0], b[1]); o.w = pk2(b[2], b[3]);
              *(u32x4*)(hyT + (size_t)ch * TS + tok0) = o;
            }
        }
      } else {
        u16* qkv = (u16*)(ws + O_QKV); u16* sg = (u16*)(ws + O_SG + (size_t)(slice & 1) * SG_BYTES);
        const bool isg = (u.pn >= 30);
        float rsv[2][4];
#pragma unroll
        for (int ai = 0; ai < 2; ++ai)
#pragma unroll
          for (int m = 0; m < 4; ++m) rsv[ai][m] = rstd1[row0 + ai * 128 + m * 16];
        __builtin_amdgcn_sched_barrier(0);
#pragma unroll
        for (int ai = 0; ai < 2; ++ai)
#pragma unroll
          for (int m = 0; m < 4; ++m) {
            const int row = row0 + ai * 128 + m * 16; const float rs = rsv[ai][m];
#pragma unroll
            for (int bj = 0; bj < 2; ++bj) {
              const int c = col0 + bj * 128;
              f32x4 a = acc[ai][bj][m][0] * rs, b = acc[ai][bj][m][1] * rs;
              if (isg) {
#pragma unroll
                for (int e = 0; e < 4; ++e) { a[e] = __builtin_amdgcn_rcpf(1.0f + __expf(-a[e])); b[e] = __builtin_amdgcn_rcpf(1.0f + __expf(-b[e])); }
              }
              u32x4 o; o.x = pk2(a[0], a[1]); o.y = pk2(a[2], a[3]); o.z = pk2(b[0], b[1]); o.w = pk2(b[2], b[3]);
              if (isg) *(u32x4*)(sg + (size_t)row * 2048 + (c - 7680)) = o; else *(u32x4*)(qkv + (size_t)row * 4608 + c) = o;
            }
          }
      }
    } else if (mode == EM_AB || mode == EM_HBR) {
      const u16* sg = (const u16*)(ws + O_SG + (size_t)(slice & 1) * SG_BYTES) + (mode == EM_HBR ? 1024 : 0); u16* mg = (u16*)(ws + O_MG) + (size_t)slice * TS * 1024;
#pragma unroll
      for (int g8 = 0; g8 < 4; ++g8) {
        const int ai = g8 >> 1, m0 = (g8 & 1) * 2;
        u32x4 sv[2][2], pv[2][2];
#pragma unroll
        for (int mm = 0; mm < 2; ++mm)
#pragma unroll
          for (int bj = 0; bj < 2; ++bj) {
            const int row = row0 + ai * 128 + (m0 + mm) * 16, c = col0 + bj * 128;
            sv[mm][bj] = *(const u32x4*)(sg + (size_t)row * 2048 + c);
            if (mode == EM_HBR) pv[mm][bj] = *(const u32x4*)(mg + (size_t)row * 1024 + c);
          }
        __builtin_amdgcn_sched_barrier(0);
#pragma unroll
        for (int mm = 0; mm < 2; ++mm)
#pragma unroll
          for (int bj = 0; bj < 2; ++bj) {
            const int m = m0 + mm, row = row0 + ai * 128 + m * 16, c = col0 + bj * 128;
            const u32x4 sx = sv[mm][bj];
            const f32x4 a = acc[ai][bj][m][0], b = acc[ai][bj][m][1];
            float v[8] = {a[0] * lo16(sx.x), a[1] * hi16(sx.x), a[2] * lo16(sx.y), a[3] * hi16(sx.y), b[0] * lo16(sx.z), b[1] * hi16(sx.z), b[2] * lo16(sx.w), b[3] * hi16(sx.w)};
            if (mode == EM_HBR) { const u32x4 p = pv[mm][bj];
              v[0] += lo16(p.x); v[1] += hi16(p.x); v[2] += lo16(p.y); v[3] += hi16(p.y); v[4] += lo16(p.z); v[5] += hi16(p.z); v[6] += lo16(p.w); v[7] += hi16(p.w); }
            u32x4 o; o.x = pk2(v[0], v[1]); o.y = pk2(v[2], v[3]); o.z = pk2(v[4], v[5]); o.w = pk2(v[6], v[7]);
            *(u32x4*)(mg + (size_t)row * 1024 + c) = o;
          }
        __builtin_amdgcn_sched_barrier(0);
      }
    } else if (mode == EM_OUT) {
      const float* xin = (u.pm < 256) ? P->in[I_XP] : P->in[I_XS] - (size_t)65536 * DM;
      u16* x2b = (u16*)(ws + O_X2B);
      float* ssq = (float*)(ws + O_SSQ2);
#pragma unroll
      for (int g8 = 0; g8 < 4; ++g8) {
        const int ai = g8 >> 1, m0 = (g8 & 1) * 2;
        f32x4 xa[2][2][2];
#pragma unroll
        for (int mm = 0; mm < 2; ++mm)
#pragma unroll
          for (int bj = 0; bj < 2; ++bj) {
            const float* xp = xin + (size_t)(row0 + ai * 128 + (m0 + mm) * 16) * DM + col0 + bj * 128;
            xa[mm][bj][0] = *(const f32x4*)xp; xa[mm][bj][1] = *(const f32x4*)(xp + 4);
          }
        __builtin_amdgcn_sched_barrier(0);
#pragma unroll
        for (int mm = 0; mm < 2; ++mm) {
          const int m = m0 + mm, row = row0 + ai * 128 + m * 16; float sq = 0.f;
#pragma unroll
          for (int bj = 0; bj < 2; ++bj) {
            const int c = col0 + bj * 128;
            const f32x4 a = acc[ai][bj][m][0] + xa[mm][bj][0], b = acc[ai][bj][m][1] + xa[mm][bj][1];
            u32x4 o; o.x = pk2(a[0], a[1]); o.y = pk2(a[2], a[3]); o.z = pk2(b[0], b[1]); o.w = pk2(b[2], b[3]);
            *(u32x4*)(x2b + (size_t)row * DM + c) = o;
            sq += a[0] * a[0] + a[1] * a[1] + a[2] * a[2] + a[3] * a[3] + b[0] * b[0] + b[1] * b[1] + b[2] * b[2] + b[3] * b[3];
          }
          sq += __shfl_xor(sq, 16); sq += __shfl_xor(sq, 32);
          if (fq == 0) ssq[(size_t)(u.pn * 4 + wc) * TALL + row] = sq;
        }
        __builtin_amdgcn_sched_barrier(0);
      }
    } else if (mode == EM_FF1) {
      const float* rs2 = (const float*)(ws + O_RSTD2) + (size_t)slice * TS; u16* hb = (u16*)(ws + O_HB + (size_t)(slice & 1) * HB_BYTES);
      float rsv[2][4];
#pragma unroll
      for (int ai = 0; ai < 2; ++ai)
#pragma unroll
        for (int m = 0; m < 4; ++m) rsv[ai][m] = rs2[row0 + ai * 128 + m * 16];
      __builtin_amdgcn_sched_barrier(0);
#pragma unroll
      for (int ai = 0; ai < 2; ++ai)
#pragma unroll
        for (int m = 0; m < 4; ++m) {
          const int row = row0 + ai * 128 + m * 16; const float rs = rsv[ai][m];
#pragma unroll
          for (int bj = 0; bj < 2; ++bj) {
            const int c = col0 + bj * 128;
            f32x4 a = acc[ai][bj][m][0] * rs, b = acc[ai][bj][m][1] * rs;
#pragma unroll
            for (int e = 0; e < 4; ++e) { a[e] = fmaxf(a[e], 0.f); a[e] *= a[e]; b[e] = fmaxf(b[e], 0.f); b[e] *= b[e]; }
            u32x4 o; o.x = pk2(a[0], a[1]); o.y = pk2(a[2], a[3]); o.z = pk2(b[0], b[1]); o.w = pk2(b[2], b[3]);
            *(u32x4*)(hb + (size_t)row * DFF + c) = o;
          }
        }
    } else {
      float* xo = P->out + (size_t)slice * TS * DM; const u16* x2b = (const u16*)(ws + O_X2B) + (size_t)slice * TS * DM;
#pragma unroll
      for (int ai = 0; ai < 2; ++ai) {
        u32x4 xv[4][2];
#pragma unroll
        for (int m = 0; m < 4; ++m)
#pragma unroll
          for (int bj = 0; bj < 2; ++bj) xv[m][bj] = *(const u32x4*)(x2b + (size_t)(row0 + ai * 128 + m * 16) * DM + col0 + bj * 128);
        __builtin_amdgcn_sched_barrier(0);
#pragma unroll
        for (int m = 0; m < 4; ++m) {
          const int row = row0 + ai * 128 + m * 16;
#pragma unroll
          for (int bj = 0; bj < 2; ++bj) {
            float* d = xo + (size_t)row * DM + col0 + bj * 128;
            const u32x4 x4 = xv[m][bj];
            f32x4 o0 = acc[ai][bj][m][0], o1 = acc[ai][bj][m][1];
            o0[0] += lo16(x4.x); o0[1] += hi16(x4.x); o0[2] += lo16(x4.y); o0[3] += hi16(x4.y); o1[0] += lo16(x4.z); o1[1] += hi16(x4.z); o1[2] += lo16(x4.w); o1[3] += hi16(x4.w);
            *(f32x4*)d = o0; *(f32x4*)(d + 4) = o1;
          }
        }
        __builtin_amdgcn_sched_barrier(0);
      }
    }
  }
};

__device__ __forceinline__ void run_gemm(const Params& P, LAS unsigned char* lds, const u16* A, const u16* Bt, int M, int N, int K, int mode, int slice, int slo, int shi) {
  pg8::Gemm g; g.A = A; g.Bt = Bt; g.M = M; g.N = N; g.K = K;
  pg8::StaticOrder S; S.init(M, N, (int)gridDim.x, (int)blockIdx.x, slo, shi);
  Epi E; E.mode = mode; E.slice = slice; E.P = &P; { unsigned char* w = P.ws; LAUNDER_S(w); E.wsl = w; }
  pg8::gemm_phase<Epi>(lds, g, S, E);
}

__device__ __forceinline__ float red2pi(float x) { const float k = rintf(x * 0.15915494309189535f); float r = fmaf(-k, 6.28125f, x); return fmaf(-k, 1.9353071795864769e-3f, r); }
__device__ __forceinline__ float psin(float x) { const float r = red2pi(x); const float r2 = r * r;
  const float hx = 0.5f * r, h2 = hx * hx;
  const float sh = hx * (1.0f + h2 * (-1.6666667e-1f + h2 * (8.3333333e-3f + h2 * (-1.9841270e-4f + h2 * (2.7557319e-6f + h2 * (-2.5052108e-8f))))));
  const float ch = 1.0f + h2 * (-0.5f + h2 * (4.1666667e-2f + h2 * (-1.3888889e-3f + h2 * (2.4801587e-5f + h2 * (-2.7557319e-7f + h2 * 2.0876757e-9f)))));
  (void)r2; return 2.0f * sh * ch; }
__device__ __forceinline__ float pcos(float x) { const float r = red2pi(x); const float hx = 0.5f * r, h2 = hx * hx;
  const float sh = hx * (1.0f + h2 * (-1.6666667e-1f + h2 * (8.3333333e-3f + h2 * (-1.9841270e-4f + h2 * (2.7557319e-6f + h2 * (-2.5052108e-8f))))));
  return 1.0f - 2.0f * sh * sh; }
__device__ __forceinline__ void transpose_tile(const float* W, int K, int N, u16* WT, int ldo, const float* g, int tile, LAS float* scr) {
  int tid = threadIdx.x; LAUNDER_V(tid); const int ntn = N / 64, kb = tile / ntn, nb = tile % ntn, k0 = kb * 64, n0 = nb * 64;
#pragma unroll
  for (int i = 0; i < 8; ++i) { const int kk = (tid >> 6) + 8 * i, nn = tid & 63; float v = W[(size_t)(k0 + kk) * N + n0 + nn]; if (g) v *= g[k0 + kk]; scr[kk * 65 + nn] = v; }
  __syncthreads();
  { const int n = tid >> 3, c = tid & 7; const LAS float* s = scr + (8 * c) * 65 + n;
    u32x4 o; o.x = pk2(s[0], s[65]); o.y = pk2(s[130], s[195]); o.z = pk2(s[260], s[325]); o.w = pk2(s[390], s[455]);
    *(u32x4*)(WT + (size_t)(n0 + n) * ldo + k0 + 8 * c) = o; }
  __syncthreads();
}

__device__ __forceinline__ void phase_prep(const Params& P, LAS unsigned char* lds) {
  unsigned char* ws = P.ws; LAUNDER_S(ws); int tid = threadIdx.x; LAUNDER_V(tid); const int bid = blockIdx.x, G = gridDim.x;
  LAS float* scr = (LAS float*)lds;
  {
    const int T_IN = 16 * 152, T_AB = 8 * 16, T_HB = 16 * 16, T_OUT = 16 * 16, T_F1 = 16 * 64, T_F2 = 64 * 16, T_W4 = 1 * 64;
    const int NT = T_IN + T_AB + T_HB + T_OUT + T_F1 + T_F2 + T_W4;
    for (int it = bid; it < NT; it += G) {
      int r = it; const float* W; int K, N, ldo; size_t off; const float* gg = nullptr;
      if (r < T_IN) { W = P.in[I_WIN]; K = 1024; N = INW; off = O_WIN; ldo = 1024; gg = P.in[I_GMIX]; }
      else if ((r -= T_IN) < T_AB) { W = P.in[I_WAB]; K = 512; N = 1024; off = O_WAB; ldo = 512; }
      else if ((r -= T_AB) < T_HB) { W = P.in[I_WHB]; K = 1024; N = 1024; off = O_WHB; ldo = 1024; }
      else if ((r -= T_HB) < T_OUT) { W = P.in[I_WOUT]; K = 1024; N = 1024; off = O_WOUT; ldo = 1024; }
      else if ((r -= T_OUT) < T_F1) { W = P.in[I_WF1]; K = 1024; N = 4096; off = O_WF1; ldo = 1024; gg = P.in[I_GMLP]; }
      else if ((r -= T_F1) < T_F2) { W = P.in[I_WF2]; K = 4096; N = 1024; off = O_WF2; ldo = 4096; }
      else { r -= T_F2; W = P.in[I_FW4]; K = 64; N = 4096; off = O_W4; ldo = 256; }
      transpose_tile(W, K, N, (u16*)(ws + off), ldo, gg, r, scr);
    }
    for (int i = bid * 512 + tid; i < 4096 * 24; i += G * 512) { const int n = i / 24, c = i % 24; unsigned z0 = 0u; LAUNDER_V(z0); *(u32x4*)((u16*)(ws + O_W4) + (size_t)n * 256 + 64 + 8 * c) = (u32x4){z0, z0, z0, z0}; }
  }
  {
    const int wave = tid >> 6, lane = tid & 63; u16* xb = (u16*)(ws + O_XB); float* rstd1 = (float*)(ws + O_RSTD1);
    for (int chunk = bid; chunk < TALL / 32; chunk += G) {
#pragma unroll 1
      for (int rr = 0; rr < 4; ++rr) {
        const int row = chunk * 32 + wave * 4 + rr;
        const float* src = row < 65536 ? P.in[I_XP] + (size_t)row * DM : P.in[I_XS] + (size_t)(row - 65536) * DM;
        f32x4 v[4]; float s = 0.f;
#pragma unroll
        for (int j = 0; j < 4; ++j) { v[j] = *(const f32x4*)(src + 4 * lane + 256 * j); s += v[j][0] * v[j][0] + v[j][1] * v[j][1] + v[j][2] * v[j][2] + v[j][3] * v[j][3]; }
#pragma unroll
        for (int o = 1; o < 64; o <<= 1) s += __shfl_xor(s, o);
#pragma unroll
        for (int j = 0; j < 4; ++j) { u32x2 o; o.x = pk2(v[j][0], v[j][1]); o.y = pk2(v[j][2], v[j][3]); *(u32x2*)(xb + (size_t)row * DM + 4 * lane + 256 * j) = o; }
        if (lane == 0) rstd1[row] = rsqrtf(s * (1.0f / 1024.0f) + 1e-6f);
      }
    }
  }
  if (bid == 0) {
    float* bt = (float*)(ws + O_BIAS);
    for (int i = tid; i < 12 * 129; i += 512) {
      const int h = i / 129, e = i % 129, delta = e - 64, gi = h >> 2, dil = 1 << (2 * gi), rel = delta * dil;
      const int side = rel > 0 ? 16 : 0, n = rel < 0 ? -rel : rel;
      int bucket;
      if (n < 8) bucket = n; else { int lg = 8 + (int)(__log2f((float)n * 0.125f) * (8.0f / 7.0f)); bucket = lg < 15 ? lg : 15; }
      bt[i] = P.in[I_RELB][(side + bucket) * 12 + h];
    }
  }
  {
    LAS float* zf = scr + 4160; LAS float* ha = zf + 8 * 36; LAS float* hb = ha + 8 * 64;
    const int pp = tid >> 6, j = tid & 63; u16* h3 = (u16*)(ws + O_H3);
    const float* w1 = P.in[I_FW1]; const float* w2 = P.in[I_FW2]; const float* w3 = P.in[I_FW3];
    const float fr = P.in[I_FFR][j], b1 = P.in[I_FB1][j], b2 = P.in[I_FB2][j], b3 = P.in[I_FB3][j];
    for (int it = bid; it < NPOS / 8; it += G) {
      const int r = it * 8 + pp; const int L = r < 2048 ? 2048 : 16384; const int i = r < 2048 ? r : r - 2048;
      if (j < 33) {
        const float ang = (6.2831853071795864f * (float)i) / (float)L; float z;
        if (j == 0) z = (float)i / (float)(L - 1);
        else { const int bi = (j - 1) & 15; const float band = 1e-4f + (float)bi * ((15.0f - 1e-4f) / 15.0f); z = (j <= 16) ? pcos(band * ang) : -psin(band * ang); }
        zf[pp * 36 + j] = z;
      }
      __syncthreads();
      { float a = b1;
_Pragma("unroll 3")
        for (int k = 0; k < 33; ++k) a += zf[pp * 36 + k] * w1[k * 64 + j]; ha[pp * 64 + j] = psin(fr * a); }
      __syncthreads();
      { float a = b2;
_Pragma("unroll 4")
        for (int k = 0; k < 64; ++k) a += ha[pp * 64 + k] * w2[k * 64 + j]; hb[pp * 64 + j] = psin(fr * a); }
      __syncthreads();
      { float a = b3;
_Pragma("unroll 4")
        for (int k = 0; k < 64; ++k) a += hb[pp * 64 + k] * w3[k * 64 + j]; const float v = psin(fr * a);
        u16* d = h3 + (size_t)r * 256; d[j] = (u16)(pk2(v, 0.f) & 0xffffu); d[64 + j] = 0; d[128 + j] = 0; d[192 + j] = 0; }
      __syncthreads();
    }
  }
}

constexpr int KROW = 272;
constexpr int KHALF = 256 * KROW;
__device__ __forceinline__ void stage_kv(const u16* src_base_  , int b, int L, int dil, int r, int m0, int M, LAS unsigned char* img, const float* gk, int ht) {
  const GAS u16* src_base = (const GAS u16*)src_base_;
  const int dch = ht & 15;
  float gv[8];
  if (gk) {
#pragma unroll
    for (int e = 0; e < 8; ++e) gv[e] = gk[dch * 8 + e];
  }
  u32x4 vv[16];
#pragma unroll
  for (int it = 0; it < 16; ++it) {
    const int kl = (ht >> 4) + 16 * it; int m = m0 - 64 + kl; m = m < 0 ? 0 : (m > M - 1 ? M - 1 : m);
    vv[it] = *(const GAS u32x4*)(src_base + (size_t)(b * L + m * dil + r) * 4608 + dch * 8);
  }
#pragma unroll
  for (int it = 0; it < 16; ++it) {
    const int kl = (ht >> 4) + 16 * it, m = m0 - 64 + kl; const bool valid = (m >= 0) && (m < M);
    u32x4 v = vv[it];
    if (!valid) { v.x = 0u; LAUNDER_V(v.x); v.y = v.x; v.z = v.x; v.w = v.x; }
    if (gk) {
      float f[8] = {lo16(v.x), hi16(v.x), lo16(v.y), hi16(v.y), lo16(v.z), hi16(v.z), lo16(v.w), hi16(v.w)};
      float s = 0.f;
#pragma unroll
      for (int e = 0; e < 8; ++e) s += f[e] * f[e];
      s += __shfl_xor(s, 1); s += __shfl_xor(s, 2); s += __shfl_xor(s, 4); s += __shfl_xor(s, 8);
      const float rs = rsqrtf(s * (1.0f / 128.0f) + 1e-6f);
      v.x = pk2(f[0] * rs * gv[0], f[1] * rs * gv[1]); v.y = pk2(f[2] * rs * gv[2], f[3] * rs * gv[3]);
      v.z = pk2(f[4] * rs * gv[4], f[5] * rs * gv[5]); v.w = pk2(f[6] * rs * gv[6], f[7] * rs * gv[7]);
    }
    *(LAS u32x4*)(img + kl * KROW + dch * 16) = v;
  }
}

__device__ __forceinline__ void attn_item(const Params& P, int slice, int item, LAS unsigned char* lds) {
  unsigned char* ws = P.ws; LAUNDER_S(ws); int tid = threadIdx.x; LAUNDER_V(tid);
  const int wave = __builtin_amdgcn_readfirstlane(tid >> 6), lane = tid & 63, half = wave >> 2, wq = wave & 3, ht = tid & 255, qn = lane & 31, h = lane >> 5;
  const int L = slice < 4 ? 2048 : 16384;
  const int hi = item * 2 + half, gi = hi >> 9, rem = hi & 511, g = rem >> 7, ci = rem & 127;
  const int dil = 1 << (2 * gi), M = L / dil, cps = L >> 7, b = ci / cps, cr = ci % cps, cpr = M >> 7, r = cr / cpr, chunk = cr % cpr, m0 = chunk * 128, head = gi * 4 + g;
  const u16* qkv = (const u16*)(ws + O_QKV);
  LAS unsigned char* img = lds + half * KHALF;
  LAS float* bl = (LAS float*)(lds + 2 * KHALF + half * 1024);
  stage_kv(qkv + 1536 + head * 128, b, L, dil, r, m0, M, img, P.in[I_GK], ht);
  if (ht < 129) bl[ht] = ((const float*)(ws + O_BIAS))[head * 129 + ht];
  const int mq = m0 + 32 * wq + qn, tokq = b * L + mq * dil + r;
  bf16x8 Qf[8];
  {
    u32x4 qv[8]; float s = 0.f;
#pragma unroll
    for (int ks = 0; ks < 8; ++ks) { qv[ks] = *(const u32x4*)(qkv + (size_t)tokq * 4608 + head * 128 + 16 * ks + 8 * h);
      const float f0 = lo16(qv[ks].x), f1 = hi16(qv[ks].x), f2 = lo16(qv[ks].y), f3 = hi16(qv[ks].y), f4 = lo16(qv[ks].z), f5 = hi16(qv[ks].z), f6 = lo16(qv[ks].w), f7 = hi16(qv[ks].w);
      s += f0 * f0 + f1 * f1 + f2 * f2 + f3 * f3 + f4 * f4 + f5 * f5 + f6 * f6 + f7 * f7; }
    s += __shfl_xor(s, 32);
    const float rs = rsqrtf(s * (1.0f / 128.0f) + 1e-6f) * 0.08838834764831845f;
    const float* gq = P.in[I_GQ];
#pragma unroll
    for (int ks = 0; ks < 8; ++ks) {
      const f32x4 g0 = *(const f32x4*)(gq + 16 * ks + 8 * h), g1 = *(const f32x4*)(gq + 16 * ks + 8 * h + 4);
      u32x4 o; o.x = pk2(lo16(qv[ks].x) * rs * g0[0], hi16(qv[ks].x) * rs * g0[1]); o.y = pk2(lo16(qv[ks].y) * rs * g0[2], hi16(qv[ks].y) * rs * g0[3]);
      o.z = pk2(lo16(qv[ks].z) * rs * g1[0], hi16(qv[ks].z) * rs * g1[1]); o.w = pk2(lo16(qv[ks].w) * rs * g1[2], hi16(qv[ks].w) * rs * g1[3]);
      Qf[ks] = __builtin_bit_cast(bf16x8, o);
    }
  }
  __syncthreads();
  f32x16 sc[5];
#pragma unroll
  for (int kt = 0; kt < 5; ++kt) {
#pragma unroll
    for (int i = 0; i < 16; ++i) sc[kt][i] = 0.f;
    const LAS unsigned char* kp = img + (32 * wq + 32 * kt + qn) * KROW + 16 * h;
#pragma unroll
    for (int ks = 0; ks < 8; ++ks) { const bf16x8 a = *(const LAS bf16x8*)(kp + 32 * ks); sc[kt] = __builtin_amdgcn_mfma_f32_32x32x16_bf16(a, Qf[ks], sc[kt], 0, 0, 0); }
  }
  float mx = -3.0e38f;
#pragma unroll
  for (int kt = 0; kt < 5; ++kt)
#pragma unroll
    for (int i = 0; i < 16; ++i) {
      const int keyl = 32 * kt + (i & 3) + 8 * (i >> 2) + 4 * h; const int delta = keyl - 64 - qn; const int km = m0 - 64 + 32 * wq + keyl;
      const bool valid = (delta >= -64) && (delta <= 64) && (km >= 0) && (km < M);
      int bi = delta + 64; bi = bi < 0 ? 0 : (bi > 128 ? 128 : bi);
      const float sv = valid ? sc[kt][i] + bl[bi] : -1e30f;
      sc[kt][i] = sv; mx = fmaxf(mx, sv);
    }
  mx = fmaxf(mx, __shfl_xor(mx, 32));
  float den = 0.f;
#pragma unroll
  for (int kt = 0; kt < 5; ++kt)
#pragma unroll
    for (int i = 0; i < 16; ++i) { const float pe = __expf(sc[kt][i] - mx); sc[kt][i] = pe; den += pe; }
  den += __shfl_xor(den, 32);
  const float inv = 1.0f / den;
  if (h == 0) ((float*)(ws + O_LSE))[((size_t)(gi * 4 + g)) * TS + b * L + r * M + mq] = mx + __logf(den);
  __syncthreads();
  stage_kv(qkv + 3072 + head * 128, b, L, dil, r, m0, M, img, nullptr, ht);
  __syncthreads();
  f32x16 oa[4];
#pragma unroll
  for (int dt = 0; dt < 4; ++dt)
#pragma unroll
    for (int i = 0; i < 16; ++i) oa[dt][i] = 0.f;
  const int i16 = lane & 15, q4 = i16 >> 2, p4 = i16 & 3, blk = (lane >> 4) & 1;
#pragma unroll
  for (int kt = 0; kt < 5; ++kt)
#pragma unroll
    for (int s = 0; s < 2; ++s) {
      u32x4 pb; pb.x = pk2(sc[kt][8 * s + 0] * inv, sc[kt][8 * s + 1] * inv); pb.y = pk2(sc[kt][8 * s + 2] * inv, sc[kt][8 * s + 3] * inv);
      pb.z = pk2(sc[kt][8 * s + 4] * inv, sc[kt][8 * s + 5] * inv); pb.w = pk2(sc[kt][8 * s + 6] * inv, sc[kt][8 * s + 7] * inv);
      const bf16x8 bfr = __builtin_bit_cast(bf16x8, pb);
      const LAS unsigned char* vp = img + (32 * wq + 32 * kt + 16 * s + 4 * h + q4) * KROW + 2 * (16 * blk + 4 * p4);
#pragma unroll
      for (int dt = 0; dt < 4; ++dt) {
        const s16x4 lo = __builtin_amdgcn_ds_read_tr16_b64_v4i16((LAS s16x4*)(vp + 64 * dt));
        const s16x4 hi4 = __builtin_amdgcn_ds_read_tr16_b64_v4i16((LAS s16x4*)(vp + 64 * dt + 8 * KROW));
        const bf16x8 a = __builtin_shufflevector(lo, hi4, 0, 1, 2, 3, 4, 5, 6, 7);
        oa[dt] = __builtin_amdgcn_mfma_f32_32x32x16_bf16(a, bfr, oa[dt], 0, 0, 0);
      }
    }
  u16* o3 = (u16*)(ws + O_O3) + ((size_t)gi * TS + tokq) * 512 + g * 128;
#pragma unroll
  for (int dt = 0; dt < 4; ++dt)
#pragma unroll
    for (int g4 = 0; g4 < 4; ++g4) {
      u32x2 o; o.x = pk2(oa[dt][4 * g4], oa[dt][4 * g4 + 1]); o.y = pk2(oa[dt][4 * g4 + 2], oa[dt][4 * g4 + 3]);
      *(u32x2*)(o3 + 32 * dt + 8 * g4 + 4 * h) = o;
    }
  __syncthreads();
}

constexpr int ZBLK = 272;
constexpr int ZS_BYTES = 128 * ZBLK + 512;
constexpr int WIN_COPY = 544, WIN_BYTES = 8 * WIN_COPY;
constexpr int CONV_GRP = 4;
constexpr int CONV_ZERO_OFF = 2 * ZS_BYTES + 2 * 2 * CONV_GRP * WIN_BYTES;

struct Sc4Raw { u32x2 v; unsigned pr, nr; };
__device__ __forceinline__ Sc4Raw sc4_load(const u16* row_, int tok) {
  const GAS u16* row = (const GAS u16*)row_;
  Sc4Raw r; r.v = *(const GAS u32x2*)(row + (unsigned)tok);
  const int ip = tok > 0 ? tok - 1 : 0, in = tok + 4 < TS ? tok + 4 : TS - 1;
  r.pr = (unsigned)row[(unsigned)ip]; r.nr = (unsigned)row[(unsigned)in];
  return r;
}
__device__ __forceinline__ f32x4 sc4_apply(const Sc4Raw& r, int tok, int L, float w0, float w1, float w2, float bb) {
  const float c0 = lo16(r.v.x), c1 = hi16(r.v.x), c2 = lo16(r.v.y), c3 = hi16(r.v.y);
  const float pv = ((tok & (L - 1)) == 0) ? 0.f : bf2f(r.pr);
  const float nx = (((tok + 4) & (L - 1)) == 0) ? 0.f : bf2f(r.nr);
  f32x4 o; o[0] = w0 * pv + w1 * c0 + w2 * c1 + bb; o[1] = w0 * c0 + w1 * c1 + w2 * c2 + bb; o[2] = w0 * c1 + w1 * c2 + w2 * c3 + bb; o[3] = w0 * c2 + w1 * c3 + w2 * nx + bb;
  return o;
}
__device__ __forceinline__ f32x4 sc4(const u16* row_, int tok, int L, float w0, float w1, float w2, float bb) { const Sc4Raw r = sc4_load(row_, tok); return sc4_apply(r, tok, L, w0, w1, w2, bb); }

__device__ __forceinline__ void conv_item(const Params& P, int slice, int item, LAS unsigned char* lds) {
  unsigned char* ws = P.ws; LAUNDER_S(ws); int tid = threadIdx.x; LAUNDER_V(tid);
  const int wave = __builtin_amdgcn_readfirstlane(tid >> 6), lane = tid & 63, chh = wave >> 2, w4 = wave & 3, wm = w4 & 1, wn = (w4 >> 1) ^ chh  , ht = tid & 255, ln = lane & 31, h = lane >> 5;
  const int c = item * 2 + chh;
  const int L = slice < 4 ? 2048 : 16384, nb = slice < 4 ? 8 : 1, nblk = 128 / nb, nbsh = slice < 4 ? 3 : 0;
  const u16* hyT = (const u16*)(ws + O_HYT);
  LAS unsigned char* Zs = lds + chh * ZS_BYTES;
  LAS unsigned char* Wn = lds + 2 * ZS_BYTES + chh * 2 * CONV_GRP * WIN_BYTES;
  const float* wsh = P.in[I_WSH]; const float* bsh = P.in[I_BSH];
  if (tid < 64) *(LAS unsigned*)(lds + CONV_ZERO_OFF + 4 * tid) = 0u;
  {
    const u16* row = hyT + (size_t)c * TS; const float w0 = wsh[c], w1 = wsh[3072 + c], w2 = wsh[6144 + c], bb = bsh[c];
#pragma unroll
    for (int hh = 0; hh < 2; ++hh) {
      Sc4Raw zr[4][2];
#pragma unroll
      for (int i4 = 0; i4 < 4; ++i4) { const int tok = 8 * (ht + 256 * (4 * hh + i4)); zr[i4][0] = sc4_load(row, tok); zr[i4][1] = sc4_load(row, tok + 4); }
      __builtin_amdgcn_sched_barrier(0);
#pragma unroll
      for (int i4 = 0; i4 < 4; ++i4) {
        const int tok = 8 * (ht + 256 * (4 * hh + i4));
        const f32x4 a = sc4_apply(zr[i4][0], tok, L, w0, w1, w2, bb), bq = sc4_apply(zr[i4][1], tok + 4, L, w0, w1, w2, bb);
        const int Bk = tok >> 7, bs = Bk / nblk;
        u32x4 o; o.x = pk2(a[0], a[1]); o.y = pk2(a[2], a[3]); o.z = pk2(bq[0], bq[1]); o.w = pk2(bq[2], bq[3]);
        *(LAS u32x4*)(Zs + Bk * ZBLK + bs * 32 + 2 * (tok & 127)) = o;
      }
      __builtin_amdgcn_sched_barrier(0);
    }
  }
  const int nsteps = 2 * nblk - 1, dmin = -(nblk - 1);
  int aro[2];
#pragma unroll
  for (int mt = 0; mt < 2; ++mt) { const int i = 64 * wm + 32 * mt + ln; aro[mt] = (i & 7) * WIN_COPY + 2 * (128 + 8 * h - (i & ~7)); }
  const int wdo = (ht >> 5) * WIN_COPY + 4 * (ht & 31);

  for (int order = 0; order < 2; ++order) {
    const GAS u16* G = (const GAS u16*)(ws + (L == 2048 ? O_G2K : O_G16K)) + (size_t)(order * 1024 + c) * (size_t)(2 * L);
    f32x16 acc[2][2];
#pragma unroll
    for (int a = 0; a < 2; ++a)
#pragma unroll
      for (int b2 = 0; b2 < 2; ++b2)
#pragma unroll
        for (int i = 0; i < 16; ++i) acc[a][b2][i] = 0.f;
    unsigned wl[8];
    const int ub = L - 129 + 2 * (ht & 31) - (ht >> 5);
#define CONV_LOADWIN(dd) do { _Pragma("unroll") for (int q = 0; q < 4; ++q) { const int u = ub + 64 * q - 128 * (dd); \
      int i0 = u + (u > L - 1 ? 1 : 0), i1 = u + 1 + (u >= L - 1 ? 1 : 0); i0 = i0 < 0 ? 0 : (i0 > 2 * L - 1 ? 2 * L - 1 : i0); i1 = i1 < 0 ? 0 : (i1 > 2 * L - 1 ? 2 * L - 1 : i1); \
      wl[2 * q] = (unsigned)G[(unsigned)i0]; wl[2 * q + 1] = (unsigned)G[(unsigned)i1]; } } while (0)
#define CONV_STOREWIN(t) do { LAS unsigned char* wd_ = Wn + ((((t) >> 2) & 1) * CONV_GRP + ((t) & 3)) * WIN_BYTES + wdo; _Pragma("unroll") for (int q = 0; q < 8; ++q) LAUNDER_V(wl[q]); _Pragma("unroll") for (int q = 0; q < 4; ++q) \
      *(LAS unsigned*)(wd_ + 128 * q) = wl[2 * q] | (wl[2 * q + 1] << 16); } while (0)
#define CONV_ROT() do { } while (0)
    { unsigned w4[CONV_GRP][8];
#pragma unroll
      for (int t0 = 0; t0 < CONV_GRP; ++t0) { CONV_LOADWIN(dmin + t0);
#pragma unroll
        for (int q = 0; q < 8; ++q) w4[t0][q] = wl[q]; }
      __builtin_amdgcn_sched_barrier(0);
#pragma unroll
      for (int t0 = 0; t0 < CONV_GRP; ++t0) {
#pragma unroll
        for (int q = 0; q < 8; ++q) wl[q] = w4[t0][q];
        CONV_STOREWIN(t0); }
    }
    __syncthreads();
    const int q0 = 2 * wn, q1 = 2 * wn + 1;
    const int lo0 = ((32 * q0) >> nbsh) - (nblk - 1), hi0 = (32 * q0 + 31) >> nbsh, lo1 = ((32 * q1) >> nbsh) - (nblk - 1), hi1 = (32 * q1 + 31) >> nbsh;
    const int n0 = 32 * q0 + ln, n1 = 32 * q1 + ln;
    const int bk0 = n0 >> nbsh, bs0 = n0 & (nb - 1); (void)n1;
    const LAS unsigned char* zb0 = Zs + (bs0 * nblk) * ZBLK + bs0 * 32 + 16 * h;
#define bk1 (bk0 + (32 >> nbsh))
#define zb1 zb0
    bf16x8 fa[10], fb[8];
#define CONV_MFMA(a_, b_, c_) __builtin_amdgcn_mfma_f32_32x32x16_bf16((a_), (b_), (c_), 0, 0, 0)
#define CONV_WB(st) (Wn + ((((st) >> 2) & 1) * CONV_GRP + ((st) & 3)) * WIN_BYTES + aro[0])
#define CONV_BP(T, e) ((((bk##T) - (e)) >= 0 && ((bk##T) - (e)) < nblk) ? zb##T + ((bk##T) - (e)) * ZBLK : (const LAS unsigned char*)(lds + CONV_ZERO_OFF))
#define CONV_TILESTEP(TT, NBP, PF, NWB, LW) do { \
      __builtin_amdgcn_sched_barrier(0); __builtin_amdgcn_s_setprio(1); \
      const LAS unsigned char* nbp_ = (NBP); const LAS unsigned char* nwb_ = (NWB); \
      if (LW) CONV_LOADWIN(d + CONV_GRP);     \
      _Pragma("unroll") for (int ks = 0; ks < 8; ++ks) { \
        acc[0][TT] = CONV_MFMA(fa[ks + 2], fb[ks], acc[0][TT]); acc[1][TT] = CONV_MFMA(fa[ks], fb[ks], acc[1][TT]); \
        fb[ks] = *(const LAS bf16x8*)(nbp_ + 32 * ks); \
        if (PF) fa[ks] = *(const LAS bf16x8*)(nwb_ + 32 * (ks - 2)); \
      } \
      if (PF) { fa[8] = *(const LAS bf16x8*)(nwb_ + 32 * 6); fa[9] = *(const LAS bf16x8*)(nwb_ + 32 * 7); } \
      __builtin_amdgcn_sched_group_barrier(0x002, 12, 0);     \
      _Pragma("unroll") for (int ks = 0; ks < 8; ++ks) { __builtin_amdgcn_sched_group_barrier(0x008, 2, 0); __builtin_amdgcn_sched_group_barrier(0x100, (PF) ? 2 : 1, 0); \
        if (LW) { __builtin_amdgcn_sched_group_barrier(0x002, 9, 0); __builtin_amdgcn_sched_group_barrier(0x020, 1, 0); } } \
      if (PF) __builtin_amdgcn_sched_group_barrier(0x100, 2, 0); \
      __builtin_amdgcn_sched_barrier(0); __builtin_amdgcn_s_setprio(0); \
    } while (0)
#define CONV_HEADT() const int step = d - dmin
#define CONV_HEAD() const int step = d - dmin; if (step + CONV_GRP < nsteps) CONV_LOADWIN(d + CONV_GRP); __builtin_amdgcn_sched_barrier(0)
#define CONV_TAIL() if (step + CONV_GRP < nsteps) CONV_STOREWIN(step + CONV_GRP); if ((step & 1) == 1 || step + 1 == nsteps) __syncthreads()
    for (int d = dmin; d < lo0; ++d) { CONV_HEAD(); CONV_TAIL(); }
    {
      const LAS unsigned char* wb = CONV_WB(lo0 - dmin); const LAS unsigned char* bp = CONV_BP(0, lo0);
#pragma unroll
      for (int k = 0; k < 10; ++k) fa[k] = *(const LAS bf16x8*)(wb + 32 * (k - 2));
#pragma unroll
      for (int ks = 0; ks < 8; ++ks) fb[ks] = *(const LAS bf16x8*)(bp + 32 * ks);
    }
    for (int d = lo0; d < lo1; ++d) { CONV_HEADT(); CONV_TILESTEP(0, CONV_BP(0, d + 1), 1, CONV_WB(step + 1), 1); CONV_TAIL(); }
    for (int d = lo1; d <= hi0; ++d) { CONV_HEADT(); CONV_TILESTEP(0, CONV_BP(1, d), 0, Wn, 1);
      CONV_TILESTEP(1, (d + 1 <= hi0) ? CONV_BP(0, d + 1) : CONV_BP(1, d + 1), 1, CONV_WB(step + 1), 0); CONV_TAIL(); }
    for (int d = hi0 + 1; d <= hi1; ++d) { CONV_HEADT(); CONV_TILESTEP(1, CONV_BP(1, d + 1), 1, CONV_WB(step + 1), 1); CONV_TAIL(); }
    for (int d = hi1 + 1; d < nblk; ++d) { CONV_HEAD(); CONV_TAIL(); }
#undef bk1
#undef zb1
#undef CONV_MFMA
#undef CONV_WB
#undef CONV_BP
#undef CONV_TILESTEP
#undef CONV_HEAD
#undef CONV_HEADT
#undef CONV_TAIL

#undef CONV_ROT
#undef CONV_LOADWIN
#undef CONV_STOREWIN
    {
      const int gc = 1024 * (order + 1) + c; const u16* grow = hyT + (size_t)gc * TS;
      const float w0 = wsh[gc], w1 = wsh[3072 + gc], w2 = wsh[6144 + gc], bb = bsh[gc], skip = P.in[I_FSK][order * 1024 + c];
      GAS u16* zt = (GAS u16*)(ws + O_ZT) + (size_t)c * TS;
      int te = threadIdx.x; LAUNDER_V(te); const int ln = te & 31, h = (te >> 5) & 1;
#pragma unroll
      for (int nt = 0; nt < 2; ++nt) {
        const int n = 32 * (2 * wn + nt) + ln, bk = n >> nbsh, bs = n & (nb - 1), Bo = bs * nblk + bk;
        Sc4Raw gr[2][4];
#pragma unroll
        for (int mt = 0; mt < 2; ++mt)
#pragma unroll
          for (int g4 = 0; g4 < 4; ++g4) gr[mt][g4] = sc4_load(grow, Bo * 128 + 64 * wm + 32 * mt + 8 * g4 + 4 * h);
        __builtin_amdgcn_sched_barrier(0);
#pragma unroll
        for (int mt = 0; mt < 2; ++mt)
#pragma unroll
          for (int g4 = 0; g4 < 4; ++g4) {
            const int s0 = 64 * wm + 32 * mt + 8 * g4 + 4 * h, tok = Bo * 128 + s0;
            LAS u32x2* zp = (LAS u32x2*)(Zs + Bo * ZBLK + bs * 32 + 2 * s0);
            const u32x2 zv = *zp; const f32x4 gt = sc4_apply(gr[mt][g4], tok, L, w0, w1, w2, bb);
            const float y0 = gt[0] * (acc[mt][nt][4 * g4 + 0] + skip * lo16(zv.x)), y1 = gt[1] * (acc[mt][nt][4 * g4 + 1] + skip * hi16(zv.x));
            const float y2 = gt[2] * (acc[mt][nt][4 * g4 + 2] + skip * lo16(zv.y)), y3 = gt[3] * (acc[mt][nt][4 * g4 + 3] + skip * hi16(zv.y));
            u32x2 o; o.x = pk2(y0, y1); o.y = pk2(y2, y3);
            if (order == 0) *zp = o; else *(GAS u32x2*)(zt + (unsigned)tok) = o;
          }
        __builtin_amdgcn_sched_barrier(0);
      }
    }
    __syncthreads();
  }
}

__device__ __forceinline__ void phase_combine(const Params& P, int slice, LAS unsigned char* lds) {
  unsigned char* ws = P.ws; LAUNDER_S(ws); int tid = threadIdx.x; LAUNDER_V(tid); const int bid = blockIdx.x, G = gridDim.x;
  const GAS float* lse = (const GAS float*)(ws + O_LSE); const GAS u16* o3 = (const GAS u16*)(ws + O_O3); GAS u16* att = (GAS u16*)(ws + O_ATT);
  const int Lc = slice < 4 ? 2048 : 16384;
  for (int idx0 = bid * 512 + tid; idx0 < TS * 64; idx0 += 2 * G * 512) {
    float l[2][3]; u32x4 ov[2][3]; int tokv[2], chv[2]; bool ok[2];
#pragma unroll
    for (int r = 0; r < 2; ++r) {
      int idx = idx0 + r * G * 512; ok[r] = idx < TS * 64; idx = ok[r] ? idx : idx0;
      const int tok = idx >> 6, ch = idx & 63, g = ch >> 4; tokv[r] = tok; chv[r] = ch;
      const int tl = tok & (Lc - 1), tb = tok - tl;
      l[r][0] = lse[(size_t)(0 + g) * TS + tok];
      l[r][1] = lse[(size_t)(4 + g) * TS + tb + (tl & 3) * (Lc >> 2) + (tl >> 2)];
      l[r][2] = lse[(size_t)(8 + g) * TS + tb + (tl & 15) * (Lc >> 4) + (tl >> 4)];
#pragma unroll
      for (int gi = 0; gi < 3; ++gi) ov[r][gi] = *(const GAS u32x4*)(o3 + ((size_t)gi * TS + tok) * 512 + ch * 8);
    }
    __builtin_amdgcn_sched_barrier(0);
#pragma unroll
    for (int r = 0; r < 2; ++r) {
      const float m = fmaxf(l[r][0], fmaxf(l[r][1], l[r][2])); float e0 = __expf(l[r][0] - m), e1 = __expf(l[r][1] - m), e2 = __expf(l[r][2] - m);
      const float inv = __builtin_amdgcn_rcpf(e0 + e1 + e2); e0 *= inv; e1 *= inv; e2 *= inv;
      const u32x4 a = ov[r][0], b = ov[r][1], cc = ov[r][2];
      u32x4 o;
      o.x = pk2(e0 * lo16(a.x) + e1 * lo16(b.x) + e2 * lo16(cc.x), e0 * hi16(a.x) + e1 * hi16(b.x) + e2 * hi16(cc.x));
      o.y = pk2(e0 * lo16(a.y) + e1 * lo16(b.y) + e2 * lo16(cc.y), e0 * hi16(a.y) + e1 * hi16(b.y) + e2 * hi16(cc.y));
      o.z = pk2(e0 * lo16(a.z) + e1 * lo16(b.z) + e2 * lo16(cc.z), e0 * hi16(a.z) + e1 * hi16(b.z) + e2 * hi16(cc.z));
      o.w = pk2(e0 * lo16(a.w) + e1 * lo16(b.w) + e2 * lo16(cc.w), e0 * hi16(a.w) + e1 * hi16(b.w) + e2 * hi16(cc.w));
      if (ok[r]) *(GAS u32x4*)(att + (size_t)tokv[r] * 512 + chv[r] * 8) = o;
    }
    __builtin_amdgcn_sched_barrier(0);
  }
  const GAS u16* zt = (const GAS u16*)(ws + O_ZT); GAS u16* zr = (GAS u16*)(ws + O_ZR); LAS u16* tl = (LAS u16*)lds;
  for (int tile0 = bid; tile0 < 16 * 256; tile0 += 8 * G) {
    u32x4 tv[8];
#pragma unroll
    for (int kk = 0; kk < 8; ++kk) { int tile = tile0 + kk * G; tile = tile < 16 * 256 ? tile : tile0;
      const int cb = tile >> 8, tb = tile & 255; tv[kk] = *(const GAS u32x4*)(zt + (size_t)(cb * 64 + (tid >> 3)) * TS + tb * 64 + 8 * (tid & 7)); }
    __builtin_amdgcn_sched_barrier(0);
#pragma unroll
    for (int kk = 0; kk < 8; ++kk) {
      const int tile = tile0 + kk * G;
      if (tile < 16 * 256) {
        const int cb = tile >> 8, tb = tile & 255, c0 = cb * 64, t0 = tb * 64;
        { const int cc = tid >> 3, k = tid & 7; LAS unsigned* d = (LAS unsigned*)(tl + cc * 72 + 8 * k); d[0] = tv[kk].x; d[1] = tv[kk].y; d[2] = tv[kk].z; d[3] = tv[kk].w; }
        __syncthreads();
        { const int tt = tid >> 3, k = tid & 7; unsigned e[8];
#pragma unroll
          for (int j = 0; j < 8; ++j) e[j] = tl[(8 * k + j) * 72 + tt];
          u32x4 o; o.x = e[0] | (e[1] << 16); o.y = e[2] | (e[3] << 16); o.z = e[4] | (e[5] << 16); o.w = e[6] | (e[7] << 16);
          *(GAS u32x4*)(zr + (size_t)(t0 + tt) * 1024 + c0 + 8 * k) = o; }
        __syncthreads();
      }
    }
  }
}

constexpr int NPHASE = 2 + 3 * NSL + 2 + (NSL + 1);
#ifndef PHM
#define PHM 0xffff
#endif
__global__ void __launch_bounds__(512) fwd_megakernel(Params P) {
  extern __shared__ __attribute__((aligned(16))) unsigned char shm[];
  LAS unsigned char* lds = (LAS unsigned char*)shm;
  cg::grid_group grid = cg::this_grid();
  if (blockIdx.x == 0 && threadIdx.x == 0) __hip_atomic_store((unsigned*)(P.ws + O_CTR), 0u, __ATOMIC_RELAXED, __HIP_MEMORY_SCOPE_AGENT);
  for (int ph = P.ph_lo; ph < P.ph_hi; ++ph) {
    unsigned char* ws = P.ws; LAUNDER_S(ws);
    if (ph == 0) { if (PHM & 1) phase_prep(P, lds); }
    else {
      const int q = ph - 2, s = q / 3, k = q % 3;
      if (ph >= 2 && ph < 2 + 3 * NSL && k == 0) {
        const int NATT = 768, NCONV = 512;
        for (int it = blockIdx.x; it < NATT + NCONV; it += gridDim.x) { if (it < NATT) attn_item(P, s, it, lds); else conv_item(P, s, it - NATT, lds); }
      } else if (ph >= 2 && ph < 2 + 3 * NSL && k == 1) {
        phase_combine(P, s, lds);
      } else {
        const int PH_OUT = 2 + 3 * NSL, c = ph - (PH_OUT + 2);
        int ng;
        if (ph == 1) ng = 2; else if (ph < PH_OUT) ng = (s < NSL - 1) ? 3 : 2; else if (ph == PH_OUT) ng = 1; else if (ph == PH_OUT + 1) ng = 0; else ng = (c == 0 || c == NSL) ? 1 : 2;
        if (ph == PH_OUT + 1) {
          const GAS float* sp = (const GAS float*)(ws + O_SSQ2); GAS float* r2 = (GAS float*)(ws + O_RSTD2);
          int t3 = threadIdx.x; LAUNDER_V(t3);
          for (int row = blockIdx.x * 512 + t3; row < TALL; row += gridDim.x * 512) {
            float pq[16];
#pragma unroll
            for (int q2 = 0; q2 < 16; ++q2) pq[q2] = sp[(size_t)q2 * TALL + row];
            float sst = 0.f;
#pragma unroll
            for (int q2 = 0; q2 < 16; ++q2) sst += pq[q2];
            r2[row] = rsqrtf(sst * (1.0f / 1024.0f) + 1e-6f); }
        }
#pragma nounroll
        for (int gi = 0; gi < ng; ++gi) {
          const u16* A; const u16* Bt; int M = TS, N = 1024, K = 1024, mode, slo = 0, shi = 0, sl = 0;
          if (ph == 1 && gi == 0) { A = (const u16*)(ws + O_H3); Bt = (const u16*)(ws + O_W4); M = NPOS; N = 4096; K = 256; mode = EM_FILT; slo = 0; shi = 1 << 30; }
          else if (ph == 1 || (ph < PH_OUT && gi == 2)) { sl = (ph == 1) ? 0 : s + 1; A = (const u16*)(ws + O_XB) + (size_t)sl * TS * DM; Bt = (const u16*)(ws + O_WIN); N = INW; mode = EM_INPROJ; slo = 18; shi = 30; }
          else if (ph < PH_OUT && gi == 0) { sl = s; A = (const u16*)(ws + O_ATT); Bt = (const u16*)(ws + O_WAB); K = 512; mode = EM_AB; }
          else if (ph < PH_OUT) { sl = s; A = (const u16*)(ws + O_ZR); Bt = (const u16*)(ws + O_WHB); mode = EM_HBR; }
          else if (ph == PH_OUT) { A = (const u16*)(ws + O_MG); Bt = (const u16*)(ws + O_WOUT); M = TALL; mode = EM_OUT; }
          else if ((c > 0 && gi == 0) || c == NSL) { sl = c - 1; A = (const u16*)(ws + O_HB + (size_t)(sl & 1) * HB_BYTES); Bt = (const u16*)(ws + O_WF2); K = DFF; mode = EM_FF2; }
          else { sl = c; A = (const u16*)(ws + O_X2B) + (size_t)sl * TS * DM; Bt = (const u16*)(ws + O_WF1); N = DFF; mode = EM_FF1; }
          run_gemm(P, lds, A, Bt, M, N, K, mode, sl, slo, shi);
        }
      }
    }
    if (ph + 1 < P.ph_hi) {
      asm volatile("s_waitcnt vmcnt(0) lgkmcnt(0)" ::: "memory");
      __syncthreads();
      if (ph == P.ph_lo) {
        if (threadIdx.x < 64) { __builtin_amdgcn_fence(__ATOMIC_RELEASE, "agent"); asm volatile("s_waitcnt vmcnt(0)" ::: "memory"); }
        __syncthreads();
        grid.sync();
        __builtin_amdgcn_fence(__ATOMIC_ACQUIRE, "agent");
        asm volatile("s_waitcnt vmcnt(0)" ::: "memory");
      } else {
        if (threadIdx.x == 0) {
          unsigned* ctr = (unsigned*)(ws + O_CTR);
          const unsigned target = (unsigned)(ph - P.ph_lo) * gridDim.x;
          __builtin_amdgcn_fence(__ATOMIC_RELEASE, "agent");
          asm volatile("s_waitcnt vmcnt(0)" ::: "memory");
          __hip_atomic_fetch_add(ctr, 1u, __ATOMIC_RELAXED, __HIP_MEMORY_SCOPE_AGENT);
          while (__hip_atomic_load(ctr, __ATOMIC_RELAXED, __HIP_MEMORY_SCOPE_AGENT) < target) __builtin_amdgcn_s_sleep(2);
          __builtin_amdgcn_fence(__ATOMIC_ACQUIRE, "agent");
          asm volatile("s_waitcnt vmcnt(0)" ::: "memory");
        }
        __syncthreads();
      }
    }
  }
}

extern "C" void kernel_launch(void* const* d_in, const int* in_sizes, int n_in, void* d_out, int out_size, void* d_ws, size_t ws_size, hipStream_t stream) {
  static int grid_blocks = 0;
  if (!grid_blocks) {
    if (n_in != 24 || ws_size < WS_END) { fprintf(stderr, "kernel_launch: unexpected n_in %d or ws_size %zu (< %zu)\n", n_in, ws_size, (size_t)WS_END); grid_blocks = -1; return; }
    int dev = 0, cus = 0, per_cu = 0;
    hipGetDevice(&dev);
    hipDeviceGetAttribute(&cus, hipDeviceAttributeMultiprocessorCount, dev);
    if (hipFuncSetAttribute((const void*)fwd_megakernel, hipFuncAttributeMaxDynamicSharedMemorySize, LDS_BYTES) != hipSuccess) { fprintf(stderr, "hipFuncSetAttribute failed\n"); grid_blocks = -1; return; }
    hipOccupancyMaxActiveBlocksPerMultiprocessor(&per_cu, (const void*)fwd_megakernel, 512, LDS_BYTES);
    if (per_cu < 1) per_cu = 1;
    grid_blocks = cus * per_cu;
  }
  if (grid_blocks < 0) return;
  Params p{};
  for (int i = 0; i < 24; ++i) p.in[i] = (const float*)d_in[i];
  p.out = (float*)d_out; p.ws = (unsigned char*)d_ws;
#if N_LAUNCH_MODE == 1
  p.ph_lo = 0; p.ph_hi = NPHASE;
  void* args[] = {&p};
  hipError_t e = hipLaunchCooperativeKernel((const void*)fwd_megakernel, dim3(grid_blocks), dim3(512), args, LDS_BYTES, stream);
  if (e != hipSuccess) fprintf(stderr, "cooperative launch failed: %s (grid %d)\n", hipGetErrorString(e), grid_blocks);
#else
  for (int ph = 0; ph < NPHASE; ++ph) {
    p.ph_lo = ph; p.ph_hi = ph + 1;
    hipLaunchKernelGGL(fwd_megakernel, dim3(grid_blocks), dim3(512), LDS_BYTES, stream, p);
  }
#endif
}
```

```cpp
#include <hip/hip_runtime.h>
#include <hip/hip_cooperative_groups.h>
#include <cstdio>
namespace cg = cooperative_groups;

#define LAS __attribute__((address_space(3)))
#define GAS __attribute__((address_space(1)))
typedef unsigned short u16;
typedef short bf16x8 __attribute__((ext_vector_type(8)));
typedef short s16x4 __attribute__((ext_vector_type(4)));
typedef float f32x4 __attribute__((ext_vector_type(4)));
typedef float f32x16 __attribute__((ext_vector_type(16)));
typedef unsigned u32x4 __attribute__((ext_vector_type(4)));
typedef unsigned u32x2 __attribute__((ext_vector_type(2)));

#ifndef N_LAUNCH_MODE
#define N_LAUNCH_MODE 1
#endif

constexpr int DM = 1024, TALL = 81920, TS = 16384, NSL = 5, INW = 9728, DFF = 4096;
constexpr int NPOS = 2048 + 16384;
constexpr int LDS_BYTES = 147456;

constexpr size_t al256(size_t x) { return (x + 255) & ~(size_t)255; }
constexpr size_t O_WIN = 0;
constexpr size_t O_WAB = O_WIN + (size_t)INW * DM * 2;
constexpr size_t O_WHB = O_WAB + (size_t)DM * 512 * 2;
constexpr size_t O_WOUT = O_WHB + (size_t)DM * DM * 2;
constexpr size_t O_WF1 = O_WOUT + (size_t)DM * DM * 2;
constexpr size_t O_WF2 = O_WF1 + (size_t)DFF * DM * 2;
constexpr size_t O_W4 = O_WF2 + (size_t)DFF * DM * 2;
constexpr size_t O_H3 = O_W4 + (size_t)4096 * 256 * 2;
constexpr size_t O_G2K = O_H3 + (size_t)NPOS * 256 * 2;
constexpr size_t O_G16K = O_G2K + (size_t)2 * 1024 * 4096 * 2;
constexpr size_t O_XB = O_G16K + (size_t)2 * 1024 * 32768 * 2;
constexpr size_t O_RSTD1 = O_XB + (size_t)TALL * DM * 2;
constexpr size_t O_SSQ2 = O_RSTD1 + (size_t)TALL * 4;
constexpr size_t O_BIAS = O_SSQ2 + (size_t)TALL * 64;
constexpr size_t O_QKV = O_BIAS + 8192;
constexpr size_t O_HYT = O_QKV + (size_t)TS * 4608 * 2;
constexpr size_t O_SG = O_HYT + (size_t)3072 * TS * 2;
constexpr size_t SG_BYTES = (size_t)TS * 2048 * 2;
constexpr size_t O_O3 = O_SG + 2 * SG_BYTES;
constexpr size_t O_LSE = O_O3 + (size_t)3 * TS * 512 * 2;
constexpr size_t O_ATT = O_LSE + (size_t)3 * TS * 4 * 4;
constexpr size_t O_ZT = O_ATT + (size_t)TS * 512 * 2;
constexpr size_t O_ZR = O_ZT + (size_t)1024 * TS * 2;
constexpr size_t O_MG = O_ZR + (size_t)TS * 1024 * 2;
constexpr size_t O_CTR = O_MG + (size_t)TALL * 1024 * 2;
constexpr size_t O_RSTD2 = O_CTR + 256;
constexpr size_t WS_END = O_RSTD2 + (size_t)TALL * 4;
static_assert(WS_END <= (size_t)1073741824, "workspace budget");
constexpr size_t O_X2B = O_XB;
constexpr size_t HB_BYTES = (size_t)TS * DFF * 2;
constexpr size_t O_HB = O_QKV;
static_assert(O_HB + 2 * HB_BYTES <= O_MG, "hidden buffers alias only per-slice mixer buffers");

struct Params {
  const float* in[24];
  float* out;
  unsigned char* ws;
  int ph_lo, ph_hi;
};
enum { I_XP = 0, I_XS, I_RELB, I_GMIX, I_WIN, I_GQ, I_GK, I_WAB, I_WSH, I_BSH, I_FW1, I_FB1, I_FW2, I_FB2, I_FW3, I_FB3, I_FW4, I_FFR, I_FSK, I_WHB, I_WOUT, I_GMLP, I_WF1, I_WF2 };

#define LAUNDER_V(x) asm volatile("" : "+v"(x))
#define LAUNDER_S(x) asm volatile("" : "+s"(x))
__device__ __forceinline__ float bf2f(unsigned v) { return __uint_as_float(v << 16); }
typedef __bf16 bf16x2_t __attribute__((ext_vector_type(2)));
typedef float f32x2_t __attribute__((ext_vector_type(2)));
__device__ __forceinline__ unsigned pk2(float lo, float hi) { const f32x2_t f = {lo, hi}; const bf16x2_t b = __builtin_convertvector(f, bf16x2_t); return __builtin_bit_cast(unsigned, b); }
__device__ __forceinline__ float lo16(unsigned v) { return __uint_as_float(v << 16); }
__device__ __forceinline__ float hi16(unsigned v) { return __uint_as_float(v & 0xffff0000u); }

namespace pg8 {
constexpr int BM = 256, BK = 64, HALF = 128, HTB = HALF * BK * 2, STAGE_BYTES = 8 * HTB, NXCD = 8, WGM = 8;
__device__ __forceinline__ int lds_byte(int r, int c) { const int st = (r >> 4) * 2 + (c >> 5), rr = r & 15, cc = c & 31, ob = rr * 64 + cc * 2; return st * 1024 + (ob ^ (((ob >> 9) & 1) << 5)); }
__device__ __forceinline__ void stage_rc(int b, int& R, int& C) { const int st = b / 1024, sb = b % 1024, swz = sb ^ (((sb >> 9) & 1) << 5); R = (st >> 1) * 16 + swz / 64; C = (st & 1) * 32 + (swz % 64) / 2; }
__device__ __forceinline__ int perm32(int rho) { const int n = rho >> 4, i = rho & 15; return 8 * (i >> 2) + 4 * n + (i & 3); }
struct Unit { int pm, pn, swap; };
struct Gemm { const u16* A; const u16* Bt; int M, N, K; };
struct StaticOrder {
  int nM, nN, nwg, G, c, slo, shi;
  __device__ void init(int M, int N, int G_, int c_, int slo_, int shi_) { nM = M / BM; nN = N / BM; nwg = nM * nN; G = G_; c = c_; slo = slo_; shi = shi_; }
  __device__ bool next(int i, Unit& u) const {
    const long L = (long)i * G + c; if (L >= nwg) return false;
    int wgid = (int)L; { const int q = nwg / NXCD, r = nwg % NXCD, xcd = wgid % NXCD, off = wgid / NXCD; wgid = (xcd < r ? xcd * (q + 1) : r * (q + 1) + (xcd - r) * q) + off; }
    const int nig = WGM * nN, gid = wgid / nig, fm = gid * WGM, gsz = (nM - fm) < WGM ? (nM - fm) : WGM;
    u.pm = fm + ((wgid % nig) % gsz); u.pn = (wgid % nig) / gsz; u.swap = (u.pn >= slo && u.pn < shi) ? 1 : 0; return true;
  }
};

template <class Epi>
__device__ __forceinline__ void gemm_phase(LAS unsigned char* lds, const Gemm g, const StaticOrder& S, const Epi& E) {
  int tid = threadIdx.x; LAUNDER_V(tid);
  const int wid = __builtin_amdgcn_readfirstlane(tid >> 6), lane = tid & 63, wr = wid >> 2, wc = wid & 3, fr = lane & 15, fq = lane >> 4;
  const int K = g.K, nt = K / BK;
  unsigned voffA[2], voffB[2];
#pragma unroll
  for (int i = 0; i < 2; ++i) { int R, C; stage_rc(tid * 16 + i * 8192, R, C); const int Rb = (R & ~31) + perm32(R & 31);
    voffA[i] = (unsigned)(R * K + C) * 2u; voffB[i] = (unsigned)(Rb * K + C) * 2u; }
  const size_t kstep = (size_t)(BK * 2);
  const size_t hstep = (size_t)HALF * K * 2;
  const size_t tstep = 2 * hstep;
  const unsigned ldsw = (unsigned)wid * 1024u;
  const int aoff = lds_byte(wr * 64 + fr, fq * 8), boff = lds_byte(wc * 32 + fr, fq * 8);
#define PG8_SA(b, h) (((b) * 2 + (h)) * HTB)
#define PG8_SB(b, h) ((4 + (b) * 2 + (h)) * HTB)
#define PG8_STAGE(bufoff, gbase, voff) do { _Pragma("unroll") for (int _i = 0; _i < 2; ++_i) \
    __builtin_amdgcn_global_load_lds((const unsigned*)((const char*)(gbase) + (voff)[_i]), (LAS unsigned*)(lds + (bufoff) + ldsw + _i * 8192), 16, 0, 0); } while (0)
#define PG8_LDA(dst, b, h) do { _Pragma("unroll") for (int m = 0; m < 4; ++m) _Pragma("unroll") for (int k = 0; k < 2; ++k) dst[m][k] = *(const LAS bf16x8*)(lds + PG8_SA(b, h) + aoff + m * 2048 + k * 1024); } while (0)
#define PG8_LDB(dst, b, h) do { _Pragma("unroll") for (int n = 0; n < 2; ++n) _Pragma("unroll") for (int k = 0; k < 2; ++k) dst[n][k] = *(const LAS bf16x8*)(lds + PG8_SB(b, h) + boff + n * 2048 + k * 1024); } while (0)
#define PG8_MMA(ai, bj, At, Bt) do { __builtin_amdgcn_s_setprio(1); _Pragma("unroll") for (int m = 0; m < 4; ++m) _Pragma("unroll") for (int n = 0; n < 2; ++n) _Pragma("unroll") for (int k = 0; k < 2; ++k) \
    acc[ai][bj][m][n] = __builtin_amdgcn_mfma_f32_16x16x32_bf16(Bt[n][k], At[m][k], acc[ai][bj][m][n], 0, 0, 0); __builtin_amdgcn_s_setprio(0); } while (0)
#define PG8_WAIT_V(n) asm volatile("s_waitcnt vmcnt(" #n ")" ::: "memory")
#define PG8_WAIT_L(n) asm volatile("s_waitcnt lgkmcnt(" #n ")" ::: "memory")
#define PG8_BAR __builtin_amdgcn_s_barrier()
#define PG8_SCHED __builtin_amdgcn_sched_barrier(0)
  Unit cur, nxt; int ui = 0;
  if (!S.next(0, cur)) return;
  f32x4 acc[2][2][4][2];
#pragma unroll
  for (int a = 0; a < 2; ++a)
#pragma unroll
    for (int b = 0; b < 2; ++b)
#pragma unroll
      for (int m = 0; m < 4; ++m)
#pragma unroll
        for (int n = 0; n < 2; ++n) acc[a][b][m][n] = (f32x4){0.f, 0.f, 0.f, 0.f};
  bf16x8 At[4][2], B0[2][2], B1[2][2];
  const char* pAm = (const char*)g.A + (size_t)cur.pm * tstep; const char* pBn = (const char*)g.Bt + (size_t)cur.pn * tstep;
  const char* cA = cur.swap ? pBn : pAm; const char* cB = cur.swap ? pAm : pBn;
  PG8_STAGE(PG8_SB(0, 0), cB, voffB); PG8_STAGE(PG8_SA(0, 0), cA, voffA); PG8_STAGE(PG8_SB(0, 1), cB + hstep, voffB); PG8_STAGE(PG8_SA(0, 1), cA + hstep, voffA);
  if (wr == 1) PG8_BAR;
  PG8_WAIT_V(4); PG8_BAR;
  PG8_STAGE(PG8_SB(1, 0), cB + kstep, voffB); PG8_STAGE(PG8_SA(1, 0), cA + kstep, voffA); PG8_STAGE(PG8_SB(1, 1), cB + hstep + kstep, voffB);
  PG8_WAIT_V(6); PG8_BAR;
  for (;;) {
    const bool has_next = S.next(ui + 1, nxt);
    const char* nA = cA; const char* nB = cB;
    if (has_next) { const char* qa = (const char*)g.A + (size_t)nxt.pm * tstep; const char* qb = (const char*)g.Bt + (size_t)nxt.pn * tstep; nA = nxt.swap ? qb : qa; nB = nxt.swap ? qa : qb; }
    for (int t = 0; t < nt; t += 2) {
      const bool last = (t == nt - 2);
      const char* a1 = cA + (size_t)(t + 1) * kstep;
      const char* a2 = last ? nA : cA + (size_t)(t + 2) * kstep; const char* b2 = last ? nB : cB + (size_t)(t + 2) * kstep;
      const char* a3 = a2 + kstep; const char* b3 = b2 + kstep;
      PG8_LDB(B0, 0, 0); PG8_SCHED; PG8_LDA(At, 0, 0); PG8_STAGE(PG8_SA(1, 1), a1 + hstep, voffA);
      PG8_WAIT_L(8); PG8_BAR; PG8_WAIT_L(0); PG8_MMA(0, 0, At, B0); PG8_BAR; PG8_SCHED;
      PG8_LDB(B1, 0, 1); PG8_STAGE(PG8_SB(0, 0), b2, voffB);
      PG8_BAR; PG8_WAIT_L(0); PG8_MMA(0, 1, At, B1); PG8_BAR;
      PG8_LDA(At, 0, 1); PG8_STAGE(PG8_SA(0, 0), a2, voffA);
      PG8_BAR; PG8_WAIT_L(0); PG8_MMA(1, 0, At, B0); PG8_BAR; PG8_SCHED;
      PG8_STAGE(PG8_SB(0, 1), b2 + hstep, voffB);
      PG8_WAIT_V(6); PG8_BAR; PG8_MMA(1, 1, At, B1); PG8_BAR;
      PG8_LDB(B0, 1, 0); PG8_SCHED; PG8_LDA(At, 1, 0); PG8_STAGE(PG8_SA(0, 1), a2 + hstep, voffA);
      PG8_WAIT_L(8); PG8_BAR; PG8_WAIT_L(0); PG8_MMA(0, 0, At, B0); PG8_BAR; PG8_SCHED;
      PG8_LDB(B1, 1, 1); PG8_STAGE(PG8_SB(1, 0), b3, voffB);
      PG8_BAR; PG8_WAIT_L(0); PG8_MMA(0, 1, At, B1); PG8_BAR;
      PG8_LDA(At, 1, 1); PG8_STAGE(PG8_SA(1, 0), a3, voffA);
      PG8_BAR; PG8_WAIT_L(0); PG8_MMA(1, 0, At, B0); PG8_BAR; PG8_SCHED;
      PG8_STAGE(PG8_SB(1, 1), b3 + hstep, voffB);
      PG8_WAIT_V(6); PG8_BAR; PG8_MMA(1, 1, At, B1); PG8_BAR;
    }
    E(acc, cur, wr, wc, fr, fq);
    if (!has_next) break;
#pragma unroll
    for (int a = 0; a < 2; ++a)
#pragma unroll
      for (int b = 0; b < 2; ++b)
#pragma unroll
        for (int m = 0; m < 4; ++m)
#pragma unroll
          for (int n = 0; n < 2; ++n) acc[a][b][m][n] = (f32x4){0.f, 0.f, 0.f, 0.f};
    cur = nxt; cA = nA; cB = nB; ++ui;
  }
  PG8_WAIT_V(0);
  if (wr == 0) PG8_BAR;
  PG8_BAR;
#undef PG8_SA
#undef PG8_SB
#undef PG8_STAGE
#undef PG8_LDA
#undef PG8_LDB
#undef PG8_MMA
#undef PG8_WAIT_V
#undef PG8_WAIT_L
#undef PG8_BAR
#undef PG8_SCHED
}
}

enum { EM_FILT = 0, EM_INPROJ, EM_AB, EM_HBR, EM_OUT, EM_FF1, EM_FF2 };
struct Epi {
  int mode, slice; const Params* P; unsigned char* wsl;
  __device__ __forceinline__ void operator()(const f32x4 (&acc)[2][2][4][2], const pg8::Unit& u, int wr, int wc, int fr, int fq) const {
    unsigned char* ws = wsl;
    const int prow = u.swap ? u.pn : u.pm, pcol = u.swap ? u.pm : u.pn;
    const int row0 = prow * 256 + wr * 64 + fr, col0 = pcol * 256 + wc * 32 + 8 * fq;
    if (mode == EM_FILT) {
      const float dmin = 3.0701134573253945f, dmax = 15.350567286626973f;
#pragma unroll
      for (int bj = 0; bj < 2; ++bj) {
        const int pr = col0 + bj * 128; const int L = pr < 2048 ? 2048 : 16384; const int p0 = pr < 2048 ? pr : pr - 2048;
        u16* G = (u16*)(ws + (L == 2048 ? O_G2K : O_G16K));
        const float tinv = 1.0f / (float)(L - 1);
#pragma unroll
        for (int ai = 0; ai < 2; ++ai)
#pragma unroll
          for (int m = 0; m < 4; ++m) {
            const int fc = row0 + ai * 128 + m * 16; const int order = fc >> 11, dir = (fc >> 10) & 1, c = fc & 1023;
            const float dl = dmin + (dmax - dmin) * ((float)c * (1.0f / 1023.0f));
            float v[8]; float dk = __expf(-(float)p0 * tinv * dl); const float dstep = __expf(-tinv * dl);
#pragma unroll
            for (int e = 0; e < 8; ++e) { v[e] = acc[ai][bj][m][e >> 2][e & 3] * dk; dk *= dstep; }
            u16* base = G + (size_t)(order * 1024 + c) * (size_t)(2 * L);
            u32x4 o;
            if (dir == 0) { o.x = pk2(v[7], v[6]); o.y = pk2(v[5], v[4]); o.z = pk2(v[3], v[2]); o.w = pk2(v[1], v[0]); *(u32x4*)(base + (L - 8 - p0)) = o; }
            else { o.x = pk2(v[0], v[1]); o.y = pk2(v[2], v[3]); o.z = pk2(v[4], v[5]); o.w = pk2(v[6], v[7]); *(u32x4*)(base + (L + p0)) = o; }
          }
      }
    } else if (mode == EM_INPROJ) {
      const float* rstd1 = (const float*)(ws + O_RSTD1) + (size_t)slice * TS;
      if (u.swap) {
        u16* hyT = (u16*)(ws + O_HYT);
        f32x4 rr[2][2];
#pragma unroll
        for (int bj = 0; bj < 2; ++bj) { rr[bj][0] = *(const f32x4*)(rstd1 + col0 + bj * 128); rr[bj][1] = *(const f32x4*)(rstd1 + col0 + bj * 128 + 4); }
        __builtin_amdgcn_sched_barrier(0);
#pragma unroll
        for (int bj = 0; bj < 2; ++bj) {
          const int tok0 = col0 + bj * 128;
#pragma unroll
          for (int ai = 0; ai < 2; ++ai)
#pragma unroll
            for (int m = 0; m < 4; ++m) {
              const int ch = row0 + ai * 128 + m * 16 - 4608;
              const f32x4 a = acc[ai][bj][m][0] * rr[bj][0], b = acc[ai][bj][m][1] * rr[bj][1];
              u32x4 o; o.x = pk2(a[0], a[1]); o.y = pk2(a[2], a[3]); o.z = pk2(b[0], b[1]); o.w = pk2(b[2], b[3]);
              *(u32x4*)(hyT + (size_t)ch * TS + tok0) = o;
            }
        }
      } else {
        u16* qkv = (u16*)(ws + O_QKV); u16* sg = (u16*)(ws + O_SG + (size_t)(slice & 1) * SG_BYTES);
        const bool isg = (u.pn >= 30);
        float rsv[2][4];
#pragma unroll
        for (int ai = 0; ai < 2; ++ai)
#pragma unroll
          for (int m = 0; m < 4; ++m) rsv[ai][m] = rstd1[row0 + ai * 128 + m * 16];
        __builtin_amdgcn_sched_barrier(0);
#pragma unroll
        for (int ai = 0; ai < 2; ++ai)
#pragma unroll
          for (int m = 0; m < 4; ++m) {
            const int row = row0 + ai * 128 + m * 16; const float rs = rsv[ai][m];
#pragma unroll
            for (int bj = 0; bj < 2; ++bj) {
              const int c = col0 + bj * 128;
              f32x4 a = acc[ai][bj][m][0] * rs, b = acc[ai][bj][m][1] * rs;
              if (isg) {
#pragma unroll
                for (int e = 0; e < 4; ++e) { a[e] = __builtin_amdgcn_rcpf(1.0f + __expf(-a[e])); b[e] = __builtin_amdgcn_rcpf(1.0f + __expf(-b[e])); }
              }
              u32x4 o; o.x = pk2(a[0], a[1]); o.y = pk2(a[2], a[3]); o.z = pk2(b[0], b[1]); o.w = pk2(b[2], b[3]);
              if (isg) *(u32x4*)(sg + (size_t)row * 2048 + (c - 7680)) = o; else *(u32x4*)(qkv + (size_t)row * 4608 + c) = o;
            }
          }
      }
    } else if (mode == EM_AB || mode == EM_HBR) {
      const u16* sg = (const u16*)(ws + O_SG + (size_t)(slice & 1) * SG_BYTES) + (mode == EM_HBR ? 1024 : 0); u16* mg = (u16*)(ws + O_MG) + (size_t)slice * TS * 1024;
#pragma unroll
      for (int g8 = 0; g8 < 4; ++g8) {
        const int ai = g8 >> 1, m0 = (g8 & 1) * 2;
        u32x4 sv[2][2], pv[2][2];
#pragma unroll
        for (int mm = 0; mm < 2; ++mm)
#pragma unroll
          for (int bj = 0; bj < 2; ++bj) {
            const int row = row0 + ai * 128 + (m0 + mm) * 16, c = col0 + bj * 128;
            sv[mm][bj] = *(const u32x4*)(sg + (size_t)row * 2048 + c);
            if (mode == EM_HBR) pv[mm][bj] = *(const u32x4*)(mg + (size_t)row * 1024 + c);
          }
        __builtin_amdgcn_sched_barrier(0);
#pragma unroll
        for (int mm = 0; mm < 2; ++mm)
#pragma unroll
          for (int bj = 0; bj < 2; ++bj) {
            const int m = m0 + mm, row = row0 + ai * 128 + m * 16, c = col0 + bj * 128;
            const u32x4 sx = sv[mm][bj];
            const f32x4 a = acc[ai][bj][m][0], b = acc[ai][bj][m][1];
            float v[8] = {a[0] * lo16(sx.x), a[1] * hi16(sx.x), a[2] * lo16(sx.y), a[3] * hi16(sx.y), b[0] * lo16(sx.z), b[1] * hi16(sx.z), b[2] * lo16(sx.w), b[3] * hi16(sx.w)};
            if (mode == EM_HBR) { const u32x4 p = pv[mm][bj];
              v[0] += lo16(p.x); v[1] += hi16(p.x); v[2] += lo16(p.y); v[3] += hi16(p.y); v[4] += lo16(p.z); v[5] += hi16(p.z); v[6] += lo16(p.w); v[7] += hi16(p.w); }
            u32x4 o; o.x = pk2(v[0], v[1]); o.y = pk2(v[2], v[3]); o.z = pk2(v[4], v[5]); o.w = pk2(v[6], v[7]);
            *(u32x4*)(mg + (size_t)row * 1024 + c) = o;
          }
        __builtin_amdgcn_sched_barrier(0);
      }
    } else if (mode == EM_OUT) {
      const float* xin = (u.pm < 256) ? P->in[I_XP] : P->in[I_XS] - (size_t)65536 * DM;
      u16* x2b = (u16*)(ws + O_X2B);
      float* ssq = (float*)(ws + O_SSQ2);
#pragma unroll
      for (int g8 = 0; g8 < 4; ++g8) {
        const int ai = g8 >> 1, m0 = (g8 & 1) * 2;
        f32x4 xa[2][2][2];
#pragma unroll
        for (int mm = 0; mm < 2; ++mm)
#pragma unroll
          for (int bj = 0; bj < 2; ++bj) {
            const float* xp = xin + (size_t)(row0 + ai * 128 + (m0 + mm) * 16) * DM + col0 + bj * 128;
            xa[mm][bj][0] = *(const f32x4*)xp; xa[mm][bj][1] = *(const f32x4*)(xp + 4);
          }
        __builtin_amdgcn_sched_barrier(0);
#pragma unroll
        for (int mm = 0; mm < 2; ++mm) {
          const int m = m0 + mm, row = row0 + ai * 128 + m * 16; float sq = 0.f;
#pragma unroll
          for (int bj = 0; bj < 2; ++bj) {
            const int c = col0 + bj * 128;
            const f32x4 a = acc[ai][bj][m][0] + xa[mm][bj][0], b = acc[ai][bj][m][1] + xa[mm][bj][1];
            u32x4 o; o.x = pk2(a[0], a[1]); o.y = pk2(a[2], a[3]); o.z = pk2(b[0], b[1]); o.w = pk2(b[2], b[3]);
            *(u32x4*)(x2b + (size_t)row * DM + c) = o;
            sq += a[0] * a[0] + a[1] * a[1] + a[2] * a[2] + a[3] * a[3] + b[0] * b[0] + b[1] * b[1] + b[2] * b[2] + b[3] * b[3];
          }
          sq += __shfl_xor(sq, 16); sq += __shfl_xor(sq, 32);
          if (fq == 0) ssq[(size_t)(u.pn * 4 + wc) * TALL + row] = sq;
        }
        __builtin_amdgcn_sched_barrier(0);
      }
    } else if (mode == EM_FF1) {
      const float* rs2 = (const float*)(ws + O_RSTD2) + (size_t)slice * TS; u16* hb = (u16*)(ws + O_HB + (size_t)(slice & 1) * HB_BYTES);
      float rsv[2][4];
#pragma unroll
      for (int ai = 0; ai < 2; ++ai)
#pragma unroll
        for (int m = 0; m < 4; ++m) rsv[ai][m] = rs2[row0 + ai * 128 + m * 16];
      __builtin_amdgcn_sched_barrier(0);
#pragma unroll
      for (int ai = 0; ai < 2; ++ai)
#pragma unroll
        for (int m = 0; m < 4; ++m) {
          const int row = row0 + ai * 128 + m * 16; const float rs = rsv[ai][m];
#pragma unroll
          for (int bj = 0; bj < 2; ++bj) {
            const int c = col0 + bj * 128;
            f32x4 a = acc[ai][bj][m][0] * rs, b = acc[ai][bj][m][1] * rs;
#pragma unroll
            for (int e = 0; e < 4; ++e) { a[e] = fmaxf(a[e], 0.f); a[e] *= a[e]; b[e] = fmaxf(b[e], 0.f); b[e] *= b[e]; }
            u32x4 o; o.x = pk2(a[0], a[1]); o.y = pk2(a[2], a[3]); o.z = pk2(b[0], b[1]); o.w = pk2(b[2], b[3]);
            *(u32x4*)(hb + (size_t)row * DFF + c) = o;
          }
        }
    } else {
      float* xo = P->out + (size_t)slice * TS * DM; const u16* x2b = (const u16*)(ws + O_X2B) + (size_t)slice * TS * DM;
#pragma unroll
      for (int ai = 0; ai < 2; ++ai) {
        u32x4 xv[4][2];
#pragma unroll
        for (int m = 0; m < 4; ++m)
#pragma unroll
          for (int bj = 0; bj < 2; ++bj) xv[m][bj] = *(const u32x4*)(x2b + (size_t)(row0 + ai * 128 + m * 16) * DM + col0 + bj * 128);
        __builtin_amdgcn_sched_barrier(0);
#pragma unroll
        for (int m = 0; m < 4; ++m) {
          const int row = row0 + ai * 128 + m * 16;
#pragma unroll
          for (int bj = 0; bj < 2; ++bj) {
            float* d = xo + (size_t)row * DM + col0 + bj * 128;
            const u32x4 x4 = xv[m][bj];
            f32x4 o0 = acc[ai][bj][m][0], o1 = acc[ai][bj][m][1];
            o0[0] += lo16(x4.x); o0[1] += hi16(x4.x); o0[2] += lo16(x4.y); o0[3] += hi16(x4.y); o1[0] += lo16(x4.z); o1[1] += hi16(x4.z); o1[2] += lo16(x4.w); o1[3] += hi16(x4.w);
            *(f32x4*)d = o0; *(f32x4*)(d + 4) = o1;
          }
        }
        __builtin_amdgcn_sched_barrier(0);
      }
    }
  }
};

__device__ __forceinline__ void run_gemm(const Params& P, LAS unsigned char* lds, const u16* A, const u16* Bt, int M, int N, int K, int mode, int slice, int slo, int shi) {
  pg8::Gemm g; g.A = A; g.Bt = Bt; g.M = M; g.N = N; g.K = K;
  pg8::StaticOrder S; S.init(M, N, (int)gridDim.x, (int)blockIdx.x, slo, shi);
  Epi E; E.mode = mode; E.slice = slice; E.P = &P; { unsigned char* w = P.ws; LAUNDER_S(w); E.wsl = w; }
  pg8::gemm_phase<Epi>(lds, g, S, E);
}

__device__ __forceinline__ float red2pi(float x) { const float k = rintf(x * 0.15915494309189535f); float r = fmaf(-k, 6.28125f, x); return fmaf(-k, 1.9353071795864769e-3f, r); }
__device__ __forceinline__ float psin(float x) { const float r = red2pi(x); const float r2 = r * r;
  const float hx = 0.5f * r, h2 = hx * hx;
  const float sh = hx * (1.0f + h2 * (-1.6666667e-1f + h2 * (8.3333333e-3f + h2 * (-1.9841270e-4f + h2 * (2.7557319e-6f + h2 * (-2.5052108e-8f))))));
  const float ch = 1.0f + h2 * (-0.5f + h2 * (4.1666667e-2f + h2 * (-1.3888889e-3f + h2 * (2.4801587e-5f + h2 * (-2.7557319e-7f + h2 * 2.0876757e-9f)))));
  (void)r2; return 2.0f * sh * ch; }
__device__ __forceinline__ float pcos(float x) { const float r = red2pi(x); const float hx = 0.5f * r, h2 = hx * hx;
  const float sh = hx * (1.0f + h2 * (-1.6666667e-1f + h2 * (8.3333333e-3f + h2 * (-1.9841270e-4f + h2 * (2.7557319e-6f + h2 * (-2.5052108e-8f))))));
  return 1.0f - 2.0f * sh * sh; }
__device__ __forceinline__ void transpose_tile(const float* W, int K, int N, u16* WT, int ldo, const float* g, int tile, LAS float* scr) {
  int tid = threadIdx.x; LAUNDER_V(tid); const int ntn = N / 64, kb = tile / ntn, nb = tile % ntn, k0 = kb * 64, n0 = nb * 64;
#pragma unroll
  for (int i = 0; i < 8; ++i) { const int kk = (tid >> 6) + 8 * i, nn = tid & 63; float v = W[(size_t)(k0 + kk) * N + n0 + nn]; if (g) v *= g[k0 + kk]; scr[kk * 65 + nn] = v; }
  __syncthreads();
  { const int n = tid >> 3, c = tid & 7; const LAS float* s = scr + (8 * c) * 65 + n;
    u32x4 o; o.x = pk2(s[0], s[65]); o.y = pk2(s[130], s[195]); o.z = pk2(s[260], s[325]); o.w = pk2(s[390], s[455]);
    *(u32x4*)(WT + (size_t)(n0 + n) * ldo + k0 + 8 * c) = o; }
  __syncthreads();
}

__device__ __forceinline__ void phase_prep(const Params& P, LAS unsigned char* lds) {
  unsigned char* ws = P.ws; LAUNDER_S(ws); int tid = threadIdx.x; LAUNDER_V(tid); const int bid = blockIdx.x, G = gridDim.x;
  LAS float* scr = (LAS float*)lds;
  {
    const int T_IN = 16 * 152, T_AB = 8 * 16, T_HB = 16 * 16, T_OUT = 16 * 16, T_F1 = 16 * 64, T_F2 = 64 * 16, T_W4 = 1 * 64;
    const int NT = T_IN + T_AB + T_HB + T_OUT + T_F1 + T_F2 + T_W4;
    for (int it = bid; it < NT; it += G) {
      int r = it; const float* W; int K, N, ldo; size_t off; const float* gg = nullptr;
      if (r < T_IN) { W = P.in[I_WIN]; K = 1024; N = INW; off = O_WIN; ldo = 1024; gg = P.in[I_GMIX]; }
      else if ((r -= T_IN) < T_AB) { W = P.in[I_WAB]; K = 512; N = 1024; off = O_WAB; ldo = 512; }
      else if ((r -= T_AB) < T_HB) { W = P.in[I_WHB]; K = 1024; N = 1024; off = O_WHB; ldo = 1024; }
      else if ((r -= T_HB) < T_OUT) { W = P.in[I_WOUT]; K = 1024; N = 1024; off = O_WOUT; ldo = 1024; }
      else if ((r -= T_OUT) < T_F1) { W = P.in[I_WF1]; K = 1024; N = 4096; off = O_WF1; ldo = 1024; gg = P.in[I_GMLP]; }
      else if ((r -= T_F1) < T_F2) { W = P.in[I_WF2]; K = 4096; N = 1024; off = O_WF2; ldo = 4096; }
      else { r -= T_F2; W = P.in[I_FW4]; K = 64; N = 4096; off = O_W4; ldo = 256; }
      transpose_tile(W, K, N, (u16*)(ws + off), ldo, gg, r, scr);
    }
    for (int i = bid * 512 + tid; i < 4096 * 24; i += G * 512) { const int n = i / 24, c = i % 24; unsigned z0 = 0u; LAUNDER_V(z0); *(u32x4*)((u16*)(ws + O_W4) + (size_t)n * 256 + 64 + 8 * c) = (u32x4){z0, z0, z0, z0}; }
  }
  {
    const int wave = tid >> 6, lane = tid & 63; u16* xb = (u16*)(ws + O_XB); float* rstd1 = (float*)(ws + O_RSTD1);
    for (int chunk = bid; chunk < TALL / 32; chunk += G) {
#pragma unroll 1
      for (int rr = 0; rr < 4; ++rr) {
        const int row = chunk * 32 + wave * 4 + rr;
        const float* src = row < 65536 ? P.in[I_XP] + (size_t)row * DM : P.in[I_XS] + (size_t)(row - 65536) * DM;
        f32x4 v[4]; float s = 0.f;
#pragma unroll
        for (int j = 0; j < 4; ++j) { v[j] = *(const f32x4*)(src + 4 * lane + 256 * j); s += v[j][0] * v[j][0] + v[j][1] * v[j][1] + v[j][2] * v[j][2] + v[j][3] * v[j][3]; }
#pragma unroll
        for (int o = 1; o < 64; o <<= 1) s += __shfl_xor(s, o);
#pragma unroll
        for (int j = 0; j < 4; ++j) { u32x2 o; o.x = pk2(v[j][0], v[j][1]); o.y = pk2(v[j][2], v[j][3]); *(u32x2*)(xb + (size_t)row * DM + 4 * lane + 256 * j) = o; }
        if (lane == 0) rstd1[row] = rsqrtf(s * (1.0f / 1024.0f) + 1e-6f);
      }
    }
  }
  if (bid == 0) {
    float* bt = (float*)(ws + O_BIAS);
    for (int i = tid; i < 12 * 129; i += 512) {
      const int h = i / 129, e = i % 129, delta = e - 64, gi = h >> 2, dil = 1 << (2 * gi), rel = delta * dil;
      const int side = rel > 0 ? 16 : 0, n = rel < 0 ? -rel : rel;
      int bucket;
      if (n < 8) bucket = n; else { int lg = 8 + (int)(__log2f((float)n * 0.125f) * (8.0f / 7.0f)); bucket = lg < 15 ? lg : 15; }
      bt[i] = P.in[I_RELB][(side + bucket) * 12 + h];
    }
  }
  {
    LAS float* zf = scr + 4160; LAS float* ha = zf + 8 * 36; LAS float* hb = ha + 8 * 64;
    const int pp = tid >> 6, j = tid & 63; u16* h3 = (u16*)(ws + O_H3);
    const float* w1 = P.in[I_FW1]; const float* w2 = P.in[I_FW2]; const float* w3 = P.in[I_FW3];
    const float fr = P.in[I_FFR][j], b1 = P.in[I_FB1][j], b2 = P.in[I_FB2][j], b3 = P.in[I_FB3][j];
    for (int it = bid; it < NPOS / 8; it += G) {
      const int r = it * 8 + pp; const int L = r < 2048 ? 2048 : 16384; const int i = r < 2048 ? r : r - 2048;
      if (j < 33) {
        const float ang = (6.2831853071795864f * (float)i) / (float)L; float z;
        if (j == 0) z = (float)i / (float)(L - 1);
        else { const int bi = (j - 1) & 15; const float band = 1e-4f + (float)bi * ((15.0f - 1e-4f) / 15.0f); z = (j <= 16) ? pcos(band * ang) : -psin(band * ang); }
        zf[pp * 36 + j] = z;
      }
      __syncthreads();
      { float a = b1;
_Pragma("unroll 3")
        for (int k = 0; k < 33; ++k) a += zf[pp * 36 + k] * w1[k * 64 + j]; ha[pp * 64 + j] = psin(fr * a); }
      __syncthreads();
      { float a = b2;
_Pragma("unroll 4")
        for (int k = 0; k < 64; ++k) a += ha[pp * 64 + k] * w2[k * 64 + j]; hb[pp * 64 + j] = psin(fr * a); }
      __syncthreads();
      { float a = b3;
_Pragma("unroll 4")
        for (int k = 0; k < 64; ++k) a += hb[pp * 64 + k] * w3[k * 64 + j]; const float v = psin(fr * a);
        u16* d = h3 + (size_t)r * 256; d[j] = (u16)(pk2(v, 0.f) & 0xffffu); d[64 + j] = 0; d[128 + j] = 0; d[192 + j] = 0; }
      __syncthreads();
    }
  }
}

constexpr int KROW = 272;
constexpr int KHALF = 256 * KROW;
__device__ __forceinline__ void stage_kv(const u16* src_base_  , int b, int L, int dil, int r, int m0, int M, LAS unsigned char* img, const float* gk, int ht) {
  const GAS u16* src_base = (const GAS u16*)src_base_;
  const int dch = ht & 15;
  float gv[8];
  if (gk) {
#pragma unroll
    for (int e = 0; e < 8; ++e) gv[e] = gk[dch * 8 + e];
  }
  u32x4 vv[16];
#pragma unroll
  for (int it = 0; it < 16; ++it) {
    const int kl = (ht >> 4) + 16 * it; int m = m0 - 64 + kl; m = m < 0 ? 0 : (m > M - 1 ? M - 1 : m);
    vv[it] = *(const GAS u32x4*)(src_base + (size_t)(b * L + m * dil + r) * 4608 + dch * 8);
  }
#pragma unroll
  for (int it = 0; it < 16; ++it) {
    const int kl = (ht >> 4) + 16 * it, m = m0 - 64 + kl; const bool valid = (m >= 0) && (m < M);
    u32x4 v = vv[it];
    if (!valid) { v.x = 0u; LAUNDER_V(v.x); v.y = v.x; v.z = v.x; v.w = v.x; }
    if (gk) {
      float f[8] = {lo16(v.x), hi16(v.x), lo16(v.y), hi16(v.y), lo16(v.z), hi16(v.z), lo16(v.w), hi16(v.w)};
      float s = 0.f;
#pragma unroll
      for (int e = 0; e < 8; ++e) s += f[e] * f[e];
      s += __shfl_xor(s, 1); s += __shfl_xor(s, 2); s += __shfl_xor(s, 4); s += __shfl_xor(s, 8);
      const float rs = rsqrtf(s * (1.0f / 128.0f) + 1e-6f);
      v.x = pk2(f[0] * rs * gv[0], f[1] * rs * gv[1]); v.y = pk2(f[2] * rs * gv[2], f[3] * rs * gv[3]);
      v.z = pk2(f[4] * rs * gv[4], f[5] * rs * gv[5]); v.w = pk2(f[6] * rs * gv[6], f[7] * rs * gv[7]);
    }
    *(LAS u32x4*)(img + kl * KROW + dch * 16) = v;
  }
}

__device__ __forceinline__ void attn_item(const Params& P, int slice, int item, LAS unsigned char* lds) {
  unsigned char* ws = P.ws; LAUNDER_S(ws); int tid = threadIdx.x; LAUNDER_V(tid);
  const int wave = __builtin_amdgcn_readfirstlane(tid >> 6), lane = tid & 63, half = wave >> 2, wq = wave & 3, ht = tid & 255, qn = lane & 31, h = lane >> 5;
  const int L = slice < 4 ? 2048 : 16384;
  const int hi = item * 2 + half, gi = hi >> 9, rem = hi & 511, g = rem >> 7, ci = rem & 127;
  const int dil = 1 << (2 * gi), M = L / dil, cps = L >> 7, b = ci / cps, cr = ci % cps, cpr = M >> 7, r = cr / cpr, chunk = cr % cpr, m0 = chunk * 128, head = gi * 4 + g;
  const u16* qkv = (const u16*)(ws + O_QKV);
  LAS unsigned char* img = lds + half * KHALF;
  LAS float* bl = (LAS float*)(lds + 2 * KHALF + half * 1024);
  stage_kv(qkv + 1536 + head * 128, b, L, dil, r, m0, M, img, P.in[I_GK], ht);
  if (ht < 129) bl[ht] = ((const float*)(ws + O_BIAS))[head * 129 + ht];
  const int mq = m0 + 32 * wq + qn, tokq = b * L + mq * dil + r;
  bf16x8 Qf[8];
  {
    u32x4 qv[8]; float s = 0.f;
#pragma unroll
    for (int ks = 0; ks < 8; ++ks) { qv[ks] = *(const u32x4*)(qkv + (size_t)tokq * 4608 + head * 128 + 16 * ks + 8 * h);
      const float f0 = lo16(qv[ks].x), f1 = hi16(qv[ks].x), f2 = lo16(qv[ks].y), f3 = hi16(qv[ks].y), f4 = lo16(qv[ks].z), f5 = hi16(qv[ks].z), f6 = lo16(qv[ks].w), f7 = hi16(qv[ks].w);
      s += f0 * f0 + f1 * f1 + f2 * f2 + f3 * f3 + f4 * f4 + f5 * f5 + f6 * f6 + f7 * f7; }
    s += __shfl_xor(s, 32);
    const float rs = rsqrtf(s * (1.0f / 128.0f) + 1e-6f) * 0.08838834764831845f;
    const float* gq = P.in[I_GQ];
#pragma unroll
    for (int ks = 0; ks < 8; ++ks) {
      const f32x4 g0 = *(const f32x4*)(gq + 16 * ks + 8 * h), g1 = *(const f32x4*)(gq + 16 * ks + 8 * h + 4);
      u32x4 o; o.x = pk2(lo16(qv[ks].x) * rs * g0[0], hi16(qv[ks].x) * rs * g0[1]); o.y = pk2(lo16(qv[ks].y) * rs * g0[2], hi16(qv[ks].y) * rs * g0[3]);
      o.z = pk2(lo16(qv[ks].z) * rs * g1[0], hi16(qv[ks].z) * rs * g1[1]); o.w = pk2(lo16(qv[ks].w) * rs * g1[2], hi16(qv[ks].w) * rs * g1[3]);
      Qf[ks] = __builtin_bit_cast(bf16x8, o);
    }
  }
  __syncthreads();
  f32x16 sc[5];
#pragma unroll
  for (int kt = 0; kt < 5; ++kt) {
#pragma unroll
    for (int i = 0; i < 16; ++i) sc[kt][i] = 0.f;
    const LAS unsigned char* kp = img + (32 * wq + 32 * kt + qn) * KROW + 16 * h;
#pragma unroll
    for (int ks = 0; ks < 8; ++ks) { const bf16x8 a = *(const LAS bf16x8*)(kp + 32 * ks); sc[kt] = __builtin_amdgcn_mfma_f32_32x32x16_bf16(a, Qf[ks], sc[kt], 0, 0, 0); }
  }
  float mx = -3.0e38f;
#pragma unroll
  for (int kt = 0; kt < 5; ++kt)
#pragma unroll
    for (int i = 0; i < 16; ++i) {
      const int keyl = 32 * kt + (i & 3) + 8 * (i >> 2) + 4 * h; const int delta = keyl - 64 - qn; const int km = m0 - 64 + 32 * wq + keyl;
      const bool valid = (delta >= -64) && (delta <= 64) && (km >= 0) && (km < M);
      int bi = delta + 64; bi = bi < 0 ? 0 : (bi > 128 ? 128 : bi);
      const float sv = valid ? sc[kt][i] + bl[bi] : -1e30f;
      sc[kt][i] = sv; mx = fmaxf(mx, sv);
    }
  mx = fmaxf(mx, __shfl_xor(mx, 32));
  float den = 0.f;
#pragma unroll
  for (int kt = 0; kt < 5; ++kt)
#pragma unroll
    for (int i = 0; i < 16; ++i) { const float pe = __expf(sc[kt][i] - mx); sc[kt][i] = pe; den += pe; }
  den += __shfl_xor(den, 32);
  const float inv = 1.0f / den;
  if (h == 0) ((float*)(ws + O_LSE))[((size_t)(gi * 4 + g)) * TS + b * L + r * M + mq] = mx + __logf(den);
  __syncthreads();
  stage_kv(qkv + 3072 + head * 128, b, L, dil, r, m0, M, img, nullptr, ht);
  __syncthreads();
  f32x16 oa[4];
#pragma unroll
  for (int dt = 0; dt < 4; ++dt)
#pragma unroll
    for (int i = 0; i < 16; ++i) oa[dt][i] = 0.f;
  const int i16 = lane & 15, q4 = i16 >> 2, p4 = i16 & 3, blk = (lane >> 4) & 1;
#pragma unroll
  for (int kt = 0; kt < 5; ++kt)
#pragma unroll
    for (int s = 0; s < 2; ++s) {
      u32x4 pb; pb.x = pk2(sc[kt][8 * s + 0] * inv, sc[kt][8 * s + 1] * inv); pb.y = pk2(sc[kt][8 * s + 2] * inv, sc[kt][8 * s + 3] * inv);
      pb.z = pk2(sc[kt][8 * s + 4] * inv, sc[kt][8 * s + 5] * inv); pb.w = pk2(sc[kt][8 * s + 6] * inv, sc[kt][8 * s + 7] * inv);
      const bf16x8 bfr = __builtin_bit_cast(bf16x8, pb);
      const LAS unsigned char* vp = img + (32 * wq + 32 * kt + 16 * s + 4 * h + q4) * KROW + 2 * (16 * blk + 4 * p4);
#pragma unroll
      for (int dt = 0; dt < 4; ++dt) {
        const s16x4 lo = __builtin_amdgcn_ds_read_tr16_b64_v4i16((LAS s16x4*)(vp + 64 * dt));
        const s16x4 hi4 = __builtin_amdgcn_ds_read_tr16_b64_v4i16((LAS s16x4*)(vp + 64 * dt + 8 * KROW));
        const bf16x8 a = __builtin_shufflevector(lo, hi4, 0, 1, 2, 3, 4, 5, 6, 7);
        oa[dt] = __builtin_amdgcn_mfma_f32_32x32x16_bf16(a, bfr, oa[dt], 0, 0, 0);
      }
    }
  u16* o3 = (u16*)(ws + O_O3) + ((size_t)gi * TS + tokq) * 512 + g * 128;
#pragma unroll
  for (int dt = 0; dt < 4; ++dt)
#pragma unroll
    for (int g4 = 0; g4 < 4; ++g4) {
      u32x2 o; o.x = pk2(oa[dt][4 * g4], oa[dt][4 * g4 + 1]); o.y = pk2(oa[dt][4 * g4 + 2], oa[dt][4 * g4 + 3]);
      *(u32x2*)(o3 + 32 * dt + 8 * g4 + 4 * h) = o;
    }
  __syncthreads();
}

constexpr int ZBLK = 272;
constexpr int ZS_BYTES = 128 * ZBLK + 512;
constexpr int WIN_COPY = 544, WIN_BYTES = 8 * WIN_COPY;
constexpr int CONV_GRP = 4;
constexpr int CONV_ZERO_OFF = 2 * ZS_BYTES + 2 * 2 * CONV_GRP * WIN_BYTES;

struct Sc4Raw { u32x2 v; unsigned pr, nr; };
__device__ __forceinline__ Sc4Raw sc4_load(const u16* row_, int tok) {
  const GAS u16* row = (const GAS u16*)row_;
  Sc4Raw r; r.v = *(const GAS u32x2*)(row + (unsigned)tok);
  const int ip = tok > 0 ? tok - 1 : 0, in = tok + 4 < TS ? tok + 4 : TS - 1;
  r.pr = (unsigned)row[(unsigned)ip]; r.nr = (unsigned)row[(unsigned)in];
  return r;
}
__device__ __forceinline__ f32x4 sc4_apply(const Sc4Raw& r, int tok, int L, float w0, float w1, float w2, float bb) {
  const float c0 = lo16(r.v.x), c1 = hi16(r.v.x), c2 = lo16(r.v.y), c3 = hi16(r.v.y);
  const float pv = ((tok & (L - 1)) == 0) ? 0.f : bf2f(r.pr);
  const float nx = (((tok + 4) & (L - 1)) == 0) ? 0.f : bf2f(r.nr);
  f32x4 o; o[0] = w0 * pv + w1 * c0 + w2 * c1 + bb; o[1] = w0 * c0 + w1 * c1 + w2 * c2 + bb; o[2] = w0 * c1 + w1 * c2 + w2 * c3 + bb; o[3] = w0 * c2 + w1 * c3 + w2 * nx + bb;
  return o;
}
__device__ __forceinline__ f32x4 sc4(const u16* row_, int tok, int L, float w0, float w1, float w2, float bb) { const Sc4Raw r = sc4_load(row_, tok); return sc4_apply(r, tok, L, w0, w1, w2, bb); }

__device__ __forceinline__ void conv_item(const Params& P, int slice, int item, LAS unsigned char* lds) {
  unsigned char* ws = P.ws; LAUNDER_S(ws); int tid = threadIdx.x; LAUNDER_V(tid);
  const int wave = __builtin_amdgcn_readfirstlane(tid >> 6), lane = tid & 63, chh = wave >> 2, w4 = wave & 3, wm = w4 & 1, wn = (w4 >> 1) ^ chh  , ht = tid & 255, l16 = lane & 15, kc = lane >> 4;
  const int c = item * 2 + chh;
  const int L = slice < 4 ? 2048 : 16384, nb = slice < 4 ? 8 : 1, nblk = 128 / nb, nbsh = slice < 4 ? 3 : 0;
  const u16* hyT = (const u16*)(ws + O_HYT);
  LAS unsigned char* Zs = lds + chh * ZS_BYTES;
  LAS unsigned char* Wn = lds + 2 * ZS_BYTES + chh * 2 * CONV_GRP * WIN_BYTES;
  const float* wsh = P.in[I_WSH]; const float* bsh = P.in[I_BSH];
  if (tid < 64) *(LAS unsigned*)(lds + CONV_ZERO_OFF + 4 * tid) = 0u;
  {
    const u16* row = hyT + (size_t)c * TS; const float w0 = wsh[c], w1 = wsh[3072 + c], w2 = wsh[6144 + c], bb = bsh[c];
#pragma unroll
    for (int hh = 0; hh < 2; ++hh) {
      Sc4Raw zr[4][2];
#pragma unroll
      for (int i4 = 0; i4 < 4; ++i4) { const int tok = 8 * (ht + 256 * (4 * hh + i4)); zr[i4][0] = sc4_load(row, tok); zr[i4][1] = sc4_load(row, tok + 4); }
      __builtin_amdgcn_sched_barrier(0);
#pragma unroll
      for (int i4 = 0; i4 < 4; ++i4) {
        const int tok = 8 * (ht + 256 * (4 * hh + i4));
        const f32x4 a = sc4_apply(zr[i4][0], tok, L, w0, w1, w2, bb), bq = sc4_apply(zr[i4][1], tok + 4, L, w0, w1, w2, bb);
        const int Bk = tok >> 7, bs = Bk / nblk;
        u32x4 o; o.x = pk2(a[0], a[1]); o.y = pk2(a[2], a[3]); o.z = pk2(bq[0], bq[1]); o.w = pk2(bq[2], bq[3]);
        *(LAS u32x4*)(Zs + Bk * ZBLK + bs * 32 + 2 * (tok & 127)) = o;
      }
      __builtin_amdgcn_sched_barrier(0);
    }
  }
  const int nsteps = 2 * nblk - 1, dmin = -(nblk - 1);
  const int aroA = (l16 & 7) * WIN_COPY + 2 * (128 + 8 * kc - 64 * wm - (l16 & 8));
  const int wdo = (ht >> 5) * WIN_COPY + 4 * (ht & 31);

  for (int order = 0; order < 2; ++order) {
    const GAS u16* G = (const GAS u16*)(ws + (L == 2048 ? O_G2K : O_G16K)) + (size_t)(order * 1024 + c) * (size_t)(2 * L);
    f32x4 acc[4][4];
#pragma unroll
    for (int a = 0; a < 4; ++a)
#pragma unroll
      for (int b2 = 0; b2 < 4; ++b2) acc[a][b2] = (f32x4){0.f, 0.f, 0.f, 0.f};
    unsigned wl[8];
    const int ub = L - 129 + 2 * (ht & 31) - (ht >> 5);
#define CONV_LOADWIN(dd) do { _Pragma("unroll") for (int q = 0; q < 4; ++q) { const int u = ub + 64 * q - 128 * (dd); \
      int i0 = u + (u > L - 1 ? 1 : 0), i1 = u + 1 + (u >= L - 1 ? 1 : 0); i0 = i0 < 0 ? 0 : (i0 > 2 * L - 1 ? 2 * L - 1 : i0); i1 = i1 < 0 ? 0 : (i1 > 2 * L - 1 ? 2 * L - 1 : i1); \
      wl[2 * q] = (unsigned)G[(unsigned)i0]; wl[2 * q + 1] = (unsigned)G[(unsigned)i1]; } } while (0)
#define CONV_STOREWIN(t) do { LAS unsigned char* wd_ = Wn + ((((t) >> 2) & 1) * CONV_GRP + ((t) & 3)) * WIN_BYTES + wdo; _Pragma("unroll") for (int q = 0; q < 8; ++q) LAUNDER_V(wl[q]); _Pragma("unroll") for (int q = 0; q < 4; ++q) \
      *(LAS unsigned*)(wd_ + 128 * q) = wl[2 * q] | (wl[2 * q + 1] << 16); } while (0)
#define CONV_ROT() do { } while (0)
    { unsigned w4[CONV_GRP][8];
#pragma unroll
      for (int t0 = 0; t0 < CONV_GRP; ++t0) { CONV_LOADWIN(dmin + t0);
#pragma unroll
        for (int q = 0; q < 8; ++q) w4[t0][q] = wl[q]; }
      __builtin_amdgcn_sched_barrier(0);
#pragma unroll
      for (int t0 = 0; t0 < CONV_GRP; ++t0) {
#pragma unroll
        for (int q = 0; q < 8; ++q) wl[q] = w4[t0][q];
        CONV_STOREWIN(t0); }
    }
    __syncthreads();
    const int q0 = 2 * wn, q1 = 2 * wn + 1;
    const int lo0 = ((32 * q0) >> nbsh) - (nblk - 1), hi0 = (32 * q0 + 31) >> nbsh, lo1 = ((32 * q1) >> nbsh) - (nblk - 1), hi1 = (32 * q1 + 31) >> nbsh;
    const int n0 = 32 * q0 + l16, n1 = 32 * q1 + l16;
    const int bk0 = n0 >> nbsh, bs0 = n0 & (nb - 1); (void)n1;
    const LAS unsigned char* zb0 = Zs + (bs0 * nblk) * ZBLK + bs0 * 32 + 16 * kc;
#define bk1 (bk0 + (32 >> nbsh))
#define zb1 zb0
    bf16x8 fa[10], fb[8];
#define CONV_MFMA(a_, b_, c_) __builtin_amdgcn_mfma_f32_16x16x32_bf16((a_), (b_), (c_), 0, 0, 0)
#define CONV_WB(st) (Wn + ((((st) >> 2) & 1) * CONV_GRP + ((st) & 3)) * WIN_BYTES + aroA)
#define CONV_BPH(T, H, e) ((((bk##T) + (H) * (16 >> nbsh) - (e)) >= 0 && ((bk##T) + (H) * (16 >> nbsh) - (e)) < nblk) ? zb##T + ((bk##T) + (H) * (16 >> nbsh) - (e)) * ZBLK : (const LAS unsigned char*)(lds + CONV_ZERO_OFF))
#define CONV_TILESTEP(TT, NBP0, NBP1, PF, NWB) do { \
      const LAS unsigned char* nb0_ = (NBP0); const LAS unsigned char* nb1_ = (NBP1); const LAS unsigned char* nwb_ = (NWB); \
      __builtin_amdgcn_sched_barrier(0); __builtin_amdgcn_s_setprio(1); \
      _Pragma("unroll") for (int ks = 0; ks < 4; ++ks) { \
        _Pragma("unroll") for (int hh = 0; hh < 2; ++hh) { \
          _Pragma("unroll") for (int mt = 0; mt < 4; ++mt) acc[mt][2 * TT + hh] = CONV_MFMA(fa[2 * ks - mt + 3], fb[4 * hh + ks], acc[mt][2 * TT + hh]); \
          fb[4 * hh + ks] = *(const LAS bf16x8*)((hh ? nb1_ : nb0_) + 64 * ks); \
        } \
        if (PF) { fa[2 * ks] = *(const LAS bf16x8*)(nwb_ + 32 * (2 * ks - 3)); fa[2 * ks + 1] = *(const LAS bf16x8*)(nwb_ + 32 * (2 * ks - 2)); } \
      } \
      if (PF) { fa[8] = *(const LAS bf16x8*)(nwb_ + 32 * 5); fa[9] = *(const LAS bf16x8*)(nwb_ + 32 * 6); } \
      _Pragma("unroll") for (int ks = 0; ks < 4; ++ks) { __builtin_amdgcn_sched_group_barrier(0x008, 4, 0); __builtin_amdgcn_sched_group_barrier(0x100, 1, 0); \
        __builtin_amdgcn_sched_group_barrier(0x008, 4, 0); __builtin_amdgcn_sched_group_barrier(0x100, (PF) ? 3 : 1, 0); } \
      if (PF) __builtin_amdgcn_sched_group_barrier(0x100, 2, 0); \
      __builtin_amdgcn_sched_barrier(0); __builtin_amdgcn_s_setprio(0); \
    } while (0)
#define CONV_HEAD() const int step = d - dmin; if (step + CONV_GRP < nsteps) CONV_LOADWIN(d + CONV_GRP); __builtin_amdgcn_sched_barrier(0)
#define CONV_TAIL() if (step + CONV_GRP < nsteps) CONV_STOREWIN(step + CONV_GRP); if ((step & 1) == 1 || step + 1 == nsteps) __syncthreads()
    for (int d = dmin; d < lo0; ++d) { CONV_HEAD(); CONV_TAIL(); }
    {
      const LAS unsigned char* wb = CONV_WB(lo0 - dmin); const LAS unsigned char* bp0 = CONV_BPH(0, 0, lo0); const LAS unsigned char* bp1 = CONV_BPH(0, 1, lo0);
#pragma unroll
      for (int k = 0; k < 10; ++k) fa[k] = *(const LAS bf16x8*)(wb + 32 * (k - 3));
#pragma unroll
      for (int ks = 0; ks < 4; ++ks) { fb[ks] = *(const LAS bf16x8*)(bp0 + 64 * ks); fb[4 + ks] = *(const LAS bf16x8*)(bp1 + 64 * ks); }
    }
    for (int d = lo0; d < lo1; ++d) { CONV_HEAD(); CONV_TILESTEP(0, CONV_BPH(0, 0, d + 1), CONV_BPH(0, 1, d + 1), 1, CONV_WB(step + 1)); CONV_TAIL(); }
    for (int d = lo1; d <= hi0; ++d) { CONV_HEAD(); CONV_TILESTEP(0, CONV_BPH(1, 0, d), CONV_BPH(1, 1, d), 0, Wn);
      CONV_TILESTEP(1, (d + 1 <= hi0) ? CONV_BPH(0, 0, d + 1) : CONV_BPH(1, 0, d + 1), (d + 1 <= hi0) ? CONV_BPH(0, 1, d + 1) : CONV_BPH(1, 1, d + 1), 1, CONV_WB(step + 1)); CONV_TAIL(); }
    for (int d = hi0 + 1; d <= hi1; ++d) { CONV_HEAD(); CONV_TILESTEP(1, CONV_BPH(1, 0, d + 1), CONV_BPH(1, 1, d + 1), 1, CONV_WB(step + 1)); CONV_TAIL(); }
    for (int d = hi1 + 1; d < nblk; ++d) { CONV_HEAD(); CONV_TAIL(); }
#undef bk1
#undef zb1
#undef CONV_MFMA
#undef CONV_WB
#undef CONV_BPH
#undef CONV_TILESTEP
#undef CONV_HEAD
#undef CONV_TAIL

#undef CONV_ROT
#undef CONV_LOADWIN
#undef CONV_STOREWIN
    {
      const int gc = 1024 * (order + 1) + c; const u16* grow = hyT + (size_t)gc * TS;
      const float w0 = wsh[gc], w1 = wsh[3072 + gc], w2 = wsh[6144 + gc], bb = bsh[gc], skip = P.in[I_FSK][order * 1024 + c];
      GAS u16* zt = (GAS u16*)(ws + O_ZT) + (size_t)c * TS;
      int te = threadIdx.x; LAUNDER_V(te); const int l16 = te & 15, kc = (te >> 4) & 3;
#pragma unroll
      for (int nt = 0; nt < 2; ++nt) {
        Sc4Raw gr[2][4];
#pragma unroll
        for (int hh = 0; hh < 2; ++hh) {
          const int n = 32 * (2 * wn + nt) + 16 * hh + l16, bk = n >> nbsh, bs = n & (nb - 1), Bo = bs * nblk + bk;
#pragma unroll
          for (int mt = 0; mt < 4; ++mt) gr[hh][mt] = sc4_load(grow, Bo * 128 + 64 * wm + 16 * mt + 4 * kc);
        }
        __builtin_amdgcn_sched_barrier(0);
#pragma unroll
        for (int hh = 0; hh < 2; ++hh) {
          const int n = 32 * (2 * wn + nt) + 16 * hh + l16, bk = n >> nbsh, bs = n & (nb - 1), Bo = bs * nblk + bk;
#pragma unroll
          for (int mt = 0; mt < 4; ++mt) {
            const int s0 = 64 * wm + 16 * mt + 4 * kc, tok = Bo * 128 + s0;
            LAS u32x2* zp = (LAS u32x2*)(Zs + Bo * ZBLK + bs * 32 + 2 * s0);
            const u32x2 zv = *zp; const f32x4 gt = sc4_apply(gr[hh][mt], tok, L, w0, w1, w2, bb);
            const f32x4 av = acc[mt][2 * nt + hh];
            const float y0 = gt[0] * (av[0] + skip * lo16(zv.x)), y1 = gt[1] * (av[1] + skip * hi16(zv.x));
            const float y2 = gt[2] * (av[2] + skip * lo16(zv.y)), y3 = gt[3] * (av[3] + skip * hi16(zv.y));
            u32x2 o; o.x = pk2(y0, y1); o.y = pk2(y2, y3);
            if (order == 0) *zp = o; else *(GAS u32x2*)(zt + (unsigned)tok) = o;
          }
        }
        __builtin_amdgcn_sched_barrier(0);
      }
    }
    __syncthreads();
  }
}

__device__ __forceinline__ void phase_combine(const Params& P, int slice, LAS unsigned char* lds) {
  unsigned char* ws = P.ws; LAUNDER_S(ws); int tid = threadIdx.x; LAUNDER_V(tid); const int bid = blockIdx.x, G = gridDim.x;
  const GAS float* lse = (const GAS float*)(ws + O_LSE); const GAS u16* o3 = (const GAS u16*)(ws + O_O3); GAS u16* att = (GAS u16*)(ws + O_ATT);
  const int Lc = slice < 4 ? 2048 : 16384;
  for (int idx0 = bid * 512 + tid; idx0 < TS * 64; idx0 += 2 * G * 512) {
    float l[2][3]; u32x4 ov[2][3]; int tokv[2], chv[2]; bool ok[2];
#pragma unroll
    for (int r = 0; r < 2; ++r) {
      int idx = idx0 + r * G * 512; ok[r] = idx < TS * 64; idx = ok[r] ? idx : idx0;
      const int tok = idx >> 6, ch = idx & 63, g = ch >> 4; tokv[r] = tok; chv[r] = ch;
      const int tl = tok & (Lc - 1), tb = tok - tl;
      l[r][0] = lse[(size_t)(0 + g) * TS + tok];
      l[r][1] = lse[(size_t)(4 + g) * TS + tb + (tl & 3) * (Lc >> 2) + (tl >> 2)];
      l[r][2] = lse[(size_t)(8 + g) * TS + tb + (tl & 15) * (Lc >> 4) + (tl >> 4)];
#pragma unroll
      for (int gi = 0; gi < 3; ++gi) ov[r][gi] = *(const GAS u32x4*)(o3 + ((size_t)gi * TS + tok) * 512 + ch * 8);
    }
    __builtin_amdgcn_sched_barrier(0);
#pragma unroll
    for (int r = 0; r < 2; ++r) {
      const float m = fmaxf(l[r][0], fmaxf(l[r][1], l[r][2])); float e0 = __expf(l[r][0] - m), e1 = __expf(l[r][1] - m), e2 = __expf(l[r][2] - m);
      const float inv = __builtin_amdgcn_rcpf(e0 + e1 + e2); e0 *= inv; e1 *= inv; e2 *= inv;
      const u32x4 a = ov[r][0], b = ov[r][1], cc = ov[r][2];
      u32x4 o;
      o.x = pk2(e0 * lo16(a.x) + e1 * lo16(b.x) + e2 * lo16(cc.x), e0 * hi16(a.x) + e1 * hi16(b.x) + e2 * hi16(cc.x));
      o.y = pk2(e0 * lo16(a.y) + e1 * lo16(b.y) + e2 * lo16(cc.y), e0 * hi16(a.y) + e1 * hi16(b.y) + e2 * hi16(cc.y));
      o.z = pk2(e0 * lo16(a.z) + e1 * lo16(b.z) + e2 * lo16(cc.z), e0 * hi16(a.z) + e1 * hi16(b.z) + e2 * hi16(cc.z));
      o.w = pk2(e0 * lo16(a.w) + e1 * lo16(b.w) + e2 * lo16(cc.w), e0 * hi16(a.w) + e1 * hi16(b.w) + e2 * hi16(cc.w));
      if (ok[r]) *(GAS u32x4*)(att + (size_t)tokv[r] * 512 + chv[r] * 8) = o;
    }
    __builtin_amdgcn_sched_barrier(0);
  }
  const GAS u16* zt = (const GAS u16*)(ws + O_ZT); GAS u16* zr = (GAS u16*)(ws + O_ZR); LAS u16* tl = (LAS u16*)lds;
  for (int tile0 = bid; tile0 < 16 * 256; tile0 += 8 * G) {
    u32x4 tv[8];
#pragma unroll
    for (int kk = 0; kk < 8; ++kk) { int tile = tile0 + kk * G; tile = tile < 16 * 256 ? tile : tile0;
      const int cb = tile >> 8, tb = tile & 255; tv[kk] = *(const GAS u32x4*)(zt + (size_t)(cb * 64 + (tid >> 3)) * TS + tb * 64 + 8 * (tid & 7)); }
    __builtin_amdgcn_sched_barrier(0);
#pragma unroll
    for (int kk = 0; kk < 8; ++kk) {
      const int tile = tile0 + kk * G;
      if (tile < 16 * 256) {
        const int cb = tile >> 8, tb = tile & 255, c0 = cb * 64, t0 = tb * 64;
        { const int cc = tid >> 3, k = tid & 7; LAS unsigned* d = (LAS unsigned*)(tl + cc * 72 + 8 * k); d[0] = tv[kk].x; d[1] = tv[kk].y; d[2] = tv[kk].z; d[3] = tv[kk].w; }
        __syncthreads();
        { const int tt = tid >> 3, k = tid & 7; unsigned e[8];
#pragma unroll
          for (int j = 0; j < 8; ++j) e[j] = tl[(8 * k + j) * 72 + tt];
          u32x4 o; o.x = e[0] | (e[1] << 16); o.y = e[2] | (e[3] << 16); o.z = e[4] | (e[5] << 16); o.w = e[6] | (e[7] << 16);
          *(GAS u32x4*)(zr + (size_t)(t0 + tt) * 1024 + c0 + 8 * k) = o; }
        __syncthreads();
      }
    }
  }
}

constexpr int NPHASE = 2 + 3 * NSL + 2 + (NSL + 1);
#ifndef PHM
#define PHM 0xffff
#endif
__global__ void __launch_bounds__(512) fwd_megakernel(Params P) {
  extern __shared__ __attribute__((aligned(16))) unsigned char shm[];
  LAS unsigned char* lds = (LAS unsigned char*)shm;
  cg::grid_group grid = cg::this_grid();
  if (blockIdx.x == 0 && threadIdx.x == 0) __hip_atomic_store((unsigned*)(P.ws + O_CTR), 0u, __ATOMIC_RELAXED, __HIP_MEMORY_SCOPE_AGENT);
  for (int ph = P.ph_lo; ph < P.ph_hi; ++ph) {
    unsigned char* ws = P.ws; LAUNDER_S(ws);
    if (ph == 0) { if (PHM & 1) phase_prep(P, lds); }
    else {
      const int q = ph - 2, s = q / 3, k = q % 3;
      if (ph >= 2 && ph < 2 + 3 * NSL && k == 0) {
        const int NATT = 768, NCONV = 512;
        for (int it = blockIdx.x; it < NATT + NCONV; it += gridDim.x) { if (it < NATT) attn_item(P, s, it, lds); else conv_item(P, s, it - NATT, lds); }
      } else if (ph >= 2 && ph < 2 + 3 * NSL && k == 1) {
        phase_combine(P, s, lds);
      } else {
        const int PH_OUT = 2 + 3 * NSL, c = ph - (PH_OUT + 2);
        int ng;
        if (ph == 1) ng = 2; else if (ph < PH_OUT) ng = (s < NSL - 1) ? 3 : 2; else if (ph == PH_OUT) ng = 1; else if (ph == PH_OUT + 1) ng = 0; else ng = (c == 0 || c == NSL) ? 1 : 2;
        if (ph == PH_OUT + 1) {
          const GAS float* sp = (const GAS float*)(ws + O_SSQ2); GAS float* r2 = (GAS float*)(ws + O_RSTD2);
          int t3 = threadIdx.x; LAUNDER_V(t3);
          for (int row = blockIdx.x * 512 + t3; row < TALL; row += gridDim.x * 512) {
            float pq[16];
#pragma unroll
            for (int q2 = 0; q2 < 16; ++q2) pq[q2] = sp[(size_t)q2 * TALL + row];
            float sst = 0.f;
#pragma unroll
            for (int q2 = 0; q2 < 16; ++q2) sst += pq[q2];
            r2[row] = rsqrtf(sst * (1.0f / 1024.0f) + 1e-6f); }
        }
#pragma nounroll
        for (int gi = 0; gi < ng; ++gi) {
          const u16* A; const u16* Bt; int M = TS, N = 1024, K = 1024, mode, slo = 0, shi = 0, sl = 0;
          if (ph == 1 && gi == 0) { A = (const u16*)(ws + O_H3); Bt = (const u16*)(ws + O_W4); M = NPOS; N = 4096; K = 256; mode = EM_FILT; slo = 0; shi = 1 << 30; }
          else if (ph == 1 || (ph < PH_OUT && gi == 2)) { sl = (ph == 1) ? 0 : s + 1; A = (const u16*)(ws + O_XB) + (size_t)sl * TS * DM; Bt = (const u16*)(ws + O_WIN); N = INW; mode = EM_INPROJ; slo = 18; shi = 30; }
          else if (ph < PH_OUT && gi == 0) { sl = s; A = (const u16*)(ws + O_ATT); Bt = (const u16*)(ws + O_WAB); K = 512; mode = EM_AB; }
          else if (ph < PH_OUT) { sl = s; A = (const u16*)(ws + O_ZR); Bt = (const u16*)(ws + O_WHB); mode = EM_HBR; }
          else if (ph == PH_OUT) { A = (const u16*)(ws + O_MG); Bt = (const u16*)(ws + O_WOUT); M = TALL; mode = EM_OUT; }
          else if ((c > 0 && gi == 0) || c == NSL) { sl = c - 1; A = (const u16*)(ws + O_HB + (size_t)(sl & 1) * HB_BYTES); Bt = (const u16*)(ws + O_WF2); K = DFF; mode = EM_FF2; }
          else { sl = c; A = (const u16*)(ws + O_X2B) + (size_t)sl * TS * DM; Bt = (const u16*)(ws + O_WF1); N = DFF; mode = EM_FF1; }
          run_gemm(P, lds, A, Bt, M, N, K, mode, sl, slo, shi);
        }
      }
    }
    if (ph + 1 < P.ph_hi) {
      asm volatile("s_waitcnt vmcnt(0) lgkmcnt(0)" ::: "memory");
      __syncthreads();
      if (ph == P.ph_lo) {
        if (threadIdx.x < 64) { __builtin_amdgcn_fence(__ATOMIC_RELEASE, "agent"); asm volatile("s_waitcnt vmcnt(0)" ::: "memory"); }
        __syncthreads();
        grid.sync();
        __builtin_amdgcn_fence(__ATOMIC_ACQUIRE, "agent");
        asm volatile("s_waitcnt vmcnt(0)" ::: "memory");
      } else {
        if (threadIdx.x == 0) {
          unsigned* ctr = (unsigned*)(ws + O_CTR);
          const unsigned target = (unsigned)(ph - P.ph_lo) * gridDim.x;
          __builtin_amdgcn_fence(__ATOMIC_RELEASE, "agent");
          asm volatile("s_waitcnt vmcnt(0)" ::: "memory");
          __hip_atomic_fetch_add(ctr, 1u, __ATOMIC_RELAXED, __HIP_MEMORY_SCOPE_AGENT);
          while (__hip_atomic_load(ctr, __ATOMIC_RELAXED, __HIP_MEMORY_SCOPE_AGENT) < target) __builtin_amdgcn_s_sleep(2);
          __builtin_amdgcn_fence(__ATOMIC_ACQUIRE, "agent");
          asm volatile("s_waitcnt vmcnt(0)" ::: "memory");
        }
        __syncthreads();
      }
    }
  }
}

extern "C" void kernel_launch(void* const* d_in, const int* in_sizes, int n_in, void* d_out, int out_size, void* d_ws, size_t ws_size, hipStream_t stream) {
  static int grid_blocks = 0;
  if (!grid_blocks) {
    if (n_in != 24 || ws_size < WS_END) { fprintf(stderr, "kernel_launch: unexpected n_in %d or ws_size %zu (< %zu)\n", n_in, ws_size, (size_t)WS_END); grid_blocks = -1; return; }
    int dev = 0, cus = 0, per_cu = 0;
    hipGetDevice(&dev);
    hipDeviceGetAttribute(&cus, hipDeviceAttributeMultiprocessorCount, dev);
    if (hipFuncSetAttribute((const void*)fwd_megakernel, hipFuncAttributeMaxDynamicSharedMemorySize, LDS_BYTES) != hipSuccess) { fprintf(stderr, "hipFuncSetAttribute failed\n"); grid_blocks = -1; return; }
    hipOccupancyMaxActiveBlocksPerMultiprocessor(&per_cu, (const void*)fwd_megakernel, 512, LDS_BYTES);
    if (per_cu < 1) per_cu = 1;
    grid_blocks = cus * per_cu;
  }
  if (grid_blocks < 0) return;
  Params p{};
  for (int i = 0; i < 24; ++i) p.in[i] = (const float*)d_in[i];
  p.out = (float*)d_out; p.ws = (unsigned char*)d_ws;
#if N_LAUNCH_MODE == 1
  p.ph_lo = 0; p.ph_hi = NPHASE;
  void* args[] = {&p};
  hipError_t e = hipLaunchCooperativeKernel((const void*)fwd_megakernel, dim3(grid_blocks), dim3(512), args, LDS_BYTES, stream);
  if (e != hipSuccess) fprintf(stderr, "cooperative launch failed: %s (grid %d)\n", hipGetErrorString(e), grid_blocks);
#else
  for (int ph = 0; ph < NPHASE; ++ph) {
    p.ph_lo = ph; p.ph_hi = ph + 1;
    hipLaunchKernelGGL(fwd_megakernel, dim3(grid_blocks), dim3(512), LDS_BYTES, stream, p);
  }
#endif
}
```

```cpp
#include <hip/hip_runtime.h>
#include <hip/hip_cooperative_groups.h>
#include <cstdio>
namespace cg = cooperative_groups;

#define LAS __attribute__((address_space(3)))
#define GAS __attribute__((address_space(1)))
typedef unsigned short u16;
typedef short bf16x8 __attribute__((ext_vector_type(8)));
typedef short s16x4 __attribute__((ext_vector_type(4)));
typedef float f32x4 __attribute__((ext_vector_type(4)));
typedef float f32x16 __attribute__((ext_vector_type(16)));
typedef unsigned u32x4 __attribute__((ext_vector_type(4)));
typedef unsigned u32x2 __attribute__((ext_vector_type(2)));

#ifndef N_LAUNCH_MODE
#define N_LAUNCH_MODE 1
#endif

constexpr int DM = 1024, TALL = 81920, TS = 16384, NSL = 5, INW = 9728, DFF = 4096;
constexpr int NPOS = 2048 + 16384;
constexpr int LDS_BYTES = 147456;

constexpr size_t al256(size_t x) { return (x + 255) & ~(size_t)255; }
constexpr size_t O_WIN = 0;
constexpr size_t O_WAB = O_WIN + (size_t)INW * DM * 2;
constexpr size_t O_WHB = O_WAB + (size_t)DM * 512 * 2;
constexpr size_t O_WOUT = O_WHB + (size_t)DM * DM * 2;
constexpr size_t O_WF1 = O_WOUT + (size_t)DM * DM * 2;
constexpr size_t O_WF2 = O_WF1 + (size_t)DFF * DM * 2;
constexpr size_t O_W4 = O_WF2 + (size_t)DFF * DM * 2;
constexpr size_t O_H3 = O_W4 + (size_t)4096 * 256 * 2;
constexpr size_t O_G2K = O_H3 + (size_t)NPOS * 256 * 2;
constexpr size_t O_G16K = O_G2K + (size_t)2 * 1024 * 4096 * 2;
constexpr size_t O_XB = O_G16K + (size_t)2 * 1024 * 32768 * 2;
constexpr size_t O_RSTD1 = O_XB + (size_t)TALL * DM * 2;
constexpr size_t O_SSQ2 = O_RSTD1 + (size_t)TALL * 4;
constexpr size_t O_BIAS = O_SSQ2 + (size_t)TALL * 64;
constexpr size_t O_QKV = O_BIAS + 8192;
constexpr size_t O_HYT = O_QKV + (size_t)TS * 4608 * 2;
constexpr size_t O_SG = O_HYT + (size_t)3072 * TS * 2;
constexpr size_t SG_BYTES = (size_t)TS * 2048 * 2;
constexpr size_t O_O3 = O_SG + 2 * SG_BYTES;
constexpr size_t O_LSE = O_O3 + (size_t)3 * TS * 512 * 2;
constexpr size_t O_ATT = O_LSE + (size_t)3 * TS * 4 * 4;
constexpr size_t O_ZT = O_ATT + (size_t)TS * 512 * 2;
constexpr size_t O_ZR = O_ZT + (size_t)1024 * TS * 2;
constexpr size_t O_MG = O_ZR + (size_t)TS * 1024 * 2;
constexpr size_t O_CTR = O_MG + (size_t)TALL * 1024 * 2;
constexpr size_t O_RSTD2 = O_CTR + 256;
constexpr size_t WS_END = O_RSTD2 + (size_t)TALL * 4;
static_assert(WS_END <= (size_t)1073741824, "workspace budget");
constexpr size_t O_X2B = O_XB;
constexpr size_t HB_BYTES = (size_t)TS * DFF * 2;
constexpr size_t O_HB = O_QKV;
static_assert(O_HB + 2 * HB_BYTES <= O_MG, "hidden buffers alias only per-slice mixer buffers");

struct Params {
  const float* in[24];
  float* out;
  unsigned char* ws;
  int ph_lo, ph_hi;
};
enum { I_XP = 0, I_XS, I_RELB, I_GMIX, I_WIN, I_GQ, I_GK, I_WAB, I_WSH, I_BSH, I_FW1, I_FB1, I_FW2, I_FB2, I_FW3, I_FB3, I_FW4, I_FFR, I_FSK, I_WHB, I_WOUT, I_GMLP, I_WF1, I_WF2 };

#define LAUNDER_V(x) asm volatile("" : "+v"(x))
#define LAUNDER_S(x) asm volatile("" : "+s"(x))
__device__ __forceinline__ float bf2f(unsigned v) { return __uint_as_float(v << 16); }
typedef __bf16 bf16x2_t __attribute__((ext_vector_type(2)));
typedef float f32x2_t __attribute__((ext_vector_type(2)));
__device__ __forceinline__ unsigned pk2(float lo, float hi) { const f32x2_t f = {lo, hi}; const bf16x2_t b = __builtin_convertvector(f, bf16x2_t); return __builtin_bit_cast(unsigned, b); }
__device__ __forceinline__ float lo16(unsigned v) { return __uint_as_float(v << 16); }
__device__ __forceinline__ float hi16(unsigned v) { return __uint_as_float(v & 0xffff0000u); }

namespace pg8 {
constexpr int BM = 256, BK = 64, HALF = 128, HTB = HALF * BK * 2, STAGE_BYTES = 8 * HTB, NXCD = 8, WGM = 8;
__device__ __forceinline__ int lds_byte(int r, int c) { const int st = (r >> 4) * 2 + (c >> 5), rr = r & 15, cc = c & 31, ob = rr * 64 + cc * 2; return st * 1024 + (ob ^ (((ob >> 9) & 1) << 5)); }
__device__ __forceinline__ void stage_rc(int b, int& R, int& C) { const int st = b / 1024, sb = b % 1024, swz = sb ^ (((sb >> 9) & 1) << 5); R = (st >> 1) * 16 + swz / 64; C = (st & 1) * 32 + (swz % 64) / 2; }
__device__ __forceinline__ int perm32(int rho) { const int n = rho >> 4, i = rho & 15; return 8 * (i >> 2) + 4 * n + (i & 3); }
struct Unit { int pm, pn, swap; };
struct Gemm { const u16* A; const u16* Bt; int M, N, K; };
struct StaticOrder {
  int nM, nN, nwg, G, c, slo, shi;
  __device__ void init(int M, int N, int G_, int c_, int slo_, int shi_) { nM = M / BM; nN = N / BM; nwg = nM * nN; G = G_; c = c_; slo = slo_; shi = shi_; }
  __device__ bool next(int i, Unit& u) const {
    const long L = (long)i * G + c; if (L >= nwg) return false;
    int wgid = (int)L; { const int q = nwg / NXCD, r = nwg % NXCD, xcd = wgid % NXCD, off = wgid / NXCD; wgid = (xcd < r ? xcd * (q + 1) : r * (q + 1) + (xcd - r) * q) + off; }
    const int nig = WGM * nN, gid = wgid / nig, fm = gid * WGM, gsz = (nM - fm) < WGM ? (nM - fm) : WGM;
    u.pm = fm + ((wgid % nig) % gsz); u.pn = (wgid % nig) / gsz; u.swap = (u.pn >= slo && u.pn < shi) ? 1 : 0; return true;
  }
};

template <class Epi>
__device__ __forceinline__ void gemm_phase(LAS unsigned char* lds, const Gemm g, const StaticOrder& S, const Epi& E) {
  int tid = threadIdx.x; LAUNDER_V(tid);
  const int wid = __builtin_amdgcn_readfirstlane(tid >> 6), lane = tid & 63, wr = wid >> 2, wc = wid & 3, fr = lane & 15, fq = lane >> 4;
  const int K = g.K, nt = K / BK;
  unsigned voffA[2], voffB[2];
#pragma unroll
  for (int i = 0; i < 2; ++i) { int R, C; stage_rc(tid * 16 + i * 8192, R, C); const int Rb = (R & ~31) + perm32(R & 31);
    voffA[i] = (unsigned)(R * K + C) * 2u; voffB[i] = (unsigned)(Rb * K + C) * 2u; }
  const size_t kstep = (size_t)(BK * 2);
  const size_t hstep = (size_t)HALF * K * 2;
  const size_t tstep = 2 * hstep;
  const unsigned ldsw = (unsigned)wid * 1024u;
  const int aoff = lds_byte(wr * 64 + fr, fq * 8), boff = lds_byte(wc * 32 + fr, fq * 8);
#define PG8_SA(b, h) (((b) * 2 + (h)) * HTB)
#define PG8_SB(b, h) ((4 + (b) * 2 + (h)) * HTB)
#define PG8_STAGE(bufoff, gbase, voff) do { _Pragma("unroll") for (int _i = 0; _i < 2; ++_i) \
    __builtin_amdgcn_global_load_lds((const unsigned*)((const char*)(gbase) + (voff)[_i]), (LAS unsigned*)(lds + (bufoff) + ldsw + _i * 8192), 16, 0, 0); } while (0)
#define PG8_LDA(dst, b, h) do { _Pragma("unroll") for (int m = 0; m < 4; ++m) _Pragma("unroll") for (int k = 0; k < 2; ++k) dst[m][k] = *(const LAS bf16x8*)(lds + PG8_SA(b, h) + aoff + m * 2048 + k * 1024); } while (0)
#define PG8_LDB(dst, b, h) do { _Pragma("unroll") for (int n = 0; n < 2; ++n) _Pragma("unroll") for (int k = 0; k < 2; ++k) dst[n][k] = *(const LAS bf16x8*)(lds + PG8_SB(b, h) + boff + n * 2048 + k * 1024); } while (0)
#define PG8_MMA(ai, bj, At, Bt) do { __builtin_amdgcn_s_setprio(1); _Pragma("unroll") for (int m = 0; m < 4; ++m) _Pragma("unroll") for (int n = 0; n < 2; ++n) _Pragma("unroll") for (int k = 0; k < 2; ++k) \
    acc[ai][bj][m][n] = __builtin_amdgcn_mfma_f32_16x16x32_bf16(Bt[n][k], At[m][k], acc[ai][bj][m][n], 0, 0, 0); __builtin_amdgcn_s_setprio(0); } while (0)
#define PG8_WAIT_V(n) asm volatile("s_waitcnt vmcnt(" #n ")" ::: "memory")
#define PG8_WAIT_L(n) asm volatile("s_waitcnt lgkmcnt(" #n ")" ::: "memory")
#define PG8_BAR __builtin_amdgcn_s_barrier()
#define PG8_SCHED __builtin_amdgcn_sched_barrier(0)
  Unit cur, nxt; int ui = 0;
  if (!S.next(0, cur)) return;
  f32x4 acc[2][2][4][2];
#pragma unroll
  for (int a = 0; a < 2; ++a)
#pragma unroll
    for (int b = 0; b < 2; ++b)
#pragma unroll
      for (int m = 0; m < 4; ++m)
#pragma unroll
        for (int n = 0; n < 2; ++n) acc[a][b][m][n] = (f32x4){0.f, 0.f, 0.f, 0.f};
  bf16x8 At[4][2], B0[2][2], B1[2][2];
  const char* pAm = (const char*)g.A + (size_t)cur.pm * tstep; const char* pBn = (const char*)g.Bt + (size_t)cur.pn * tstep;
  const char* cA = cur.swap ? pBn : pAm; const char* cB = cur.swap ? pAm : pBn;
  PG8_STAGE(PG8_SB(0, 0), cB, voffB); PG8_STAGE(PG8_SA(0, 0), cA, voffA); PG8_STAGE(PG8_SB(0, 1), cB + hstep, voffB); PG8_STAGE(PG8_SA(0, 1), cA + hstep, voffA);
  if (wr == 1) PG8_BAR;
  PG8_WAIT_V(4); PG8_BAR;
  PG8_STAGE(PG8_SB(1, 0), cB + kstep, voffB); PG8_STAGE(PG8_SA(1, 0), cA + kstep, voffA); PG8_STAGE(PG8_SB(1, 1), cB + hstep + kstep, voffB);
  PG8_WAIT_V(6); PG8_BAR;
  for (;;) {
    const bool has_next = S.next(ui + 1, nxt);
    const char* nA = cA; const char* nB = cB;
    if (has_next) { const char* qa = (const char*)g.A + (size_t)nxt.pm * tstep; const char* qb = (const char*)g.Bt + (size_t)nxt.pn * tstep; nA = nxt.swap ? qb : qa; nB = nxt.swap ? qa : qb; }
    for (int t = 0; t < nt; t += 2) {
      const bool last = (t == nt - 2);
      const char* a1 = cA + (size_t)(t + 1) * kstep;
      const char* a2 = last ? nA : cA + (size_t)(t + 2) * kstep; const char* b2 = last ? nB : cB + (size_t)(t + 2) * kstep;
      const char* a3 = a2 + kstep; const char* b3 = b2 + kstep;
      PG8_LDB(B0, 0, 0); PG8_SCHED; PG8_LDA(At, 0, 0); PG8_STAGE(PG8_SA(1, 1), a1 + hstep, voffA);
      PG8_WAIT_L(8); PG8_BAR; PG8_WAIT_L(0); PG8_MMA(0, 0, At, B0); PG8_BAR; PG8_SCHED;
      PG8_LDB(B1, 0, 1); PG8_STAGE(PG8_SB(0, 0), b2, voffB);
      PG8_BAR; PG8_WAIT_L(0); PG8_MMA(0, 1, At, B1); PG8_BAR;
      PG8_LDA(At, 0, 1); PG8_STAGE(PG8_SA(0, 0), a2, voffA);
      PG8_BAR; PG8_WAIT_L(0); PG8_MMA(1, 0, At, B0); PG8_BAR; PG8_SCHED;
      PG8_STAGE(PG8_SB(0, 1), b2 + hstep, voffB);
      PG8_WAIT_V(6); PG8_BAR; PG8_MMA(1, 1, At, B1); PG8_BAR;
      PG8_LDB(B0, 1, 0); PG8_SCHED; PG8_LDA(At, 1, 0); PG8_STAGE(PG8_SA(0, 1), a2 + hstep, voffA);
      PG8_WAIT_L(8); PG8_BAR; PG8_WAIT_L(0); PG8_MMA(0, 0, At, B0); PG8_BAR; PG8_SCHED;
      PG8_LDB(B1, 1, 1); PG8_STAGE(PG8_SB(1, 0), b3, voffB);
      PG8_BAR; PG8_WAIT_L(0); PG8_MMA(0, 1, At, B1); PG8_BAR;
      PG8_LDA(At, 1, 1); PG8_STAGE(PG8_SA(1, 0), a3, voffA);
      PG8_BAR; PG8_WAIT_L(0); PG8_MMA(1, 0, At, B0); PG8_BAR; PG8_SCHED;
      PG8_STAGE(PG8_SB(1, 1), b3 + hstep, voffB);
      PG8_WAIT_V(6); PG8_BAR; PG8_MMA(1, 1, At, B1); PG8_BAR;
    }
    E(acc, cur, wr, wc, fr, fq);
    if (!has_next) break;
#pragma unroll
    for (int a = 0; a < 2; ++a)
#pragma unroll
      for (int b = 0; b < 2; ++b)
#pragma unroll
        for (int m = 0; m < 4; ++m)
#pragma unroll
          for (int n = 0; n < 2; ++n) acc[a][b][m][n] = (f32x4){0.f, 0.f, 0.f, 0.f};
    cur = nxt; cA = nA; cB = nB; ++ui;
  }
  PG8_WAIT_V(0);
  if (wr == 0) PG8_BAR;
  PG8_BAR;
#undef PG8_SA
#undef PG8_SB
#undef PG8_STAGE
#undef PG8_LDA
#undef PG8_LDB
#undef PG8_MMA
#undef PG8_WAIT_V
#undef PG8_WAIT_L
#undef PG8_BAR
#undef PG8_SCHED
}
}

enum { EM_FILT = 0, EM_INPROJ, EM_AB, EM_HBR, EM_OUT, EM_FF1, EM_FF2 };
struct Epi {
  int mode, slice; const Params* P; unsigned char* wsl;
  __device__ __forceinline__ void operator()(const f32x4 (&acc)[2][2][4][2], const pg8::Unit& u, int wr, int wc, int fr, int fq) const {
    unsigned char* ws = wsl;
    const int prow = u.swap ? u.pn : u.pm, pcol = u.swap ? u.pm : u.pn;
    const int row0 = prow * 256 + wr * 64 + fr, col0 = pcol * 256 + wc * 32 + 8 * fq;
    if (mode == EM_FILT) {
      const float dmin = 3.0701134573253945f, dmax = 15.350567286626973f;
#pragma unroll
      for (int bj = 0; bj < 2; ++bj) {
        const int pr = col0 + bj * 128; const int L = pr < 2048 ? 2048 : 16384; const int p0 = pr < 2048 ? pr : pr - 2048;
        u16* G = (u16*)(ws + (L == 2048 ? O_G2K : O_G16K));
        const float tinv = 1.0f / (float)(L - 1);
#pragma unroll
        for (int ai = 0; ai < 2; ++ai)
#pragma unroll
          for (int m = 0; m < 4; ++m) {
            const int fc = row0 + ai * 128 + m * 16; const int order = fc >> 11, dir = (fc >> 10) & 1, c = fc & 1023;
            const float dl = dmin + (dmax - dmin) * ((float)c * (1.0f / 1023.0f));
            float v[8]; float dk = __expf(-(float)p0 * tinv * dl); const float dstep = __expf(-tinv * dl);
#pragma unroll
            for (int e = 0; e < 8; ++e) { v[e] = acc[ai][bj][m][e >> 2][e & 3] * dk; dk *= dstep; }
            u16* base = G + (size_t)(order * 1024 + c) * (size_t)(2 * L);
            u32x4 o;
            if (dir == 0) { o.x = pk2(v[7], v[6]); o.y = pk2(v[5], v[4]); o.z = pk2(v[3], v[2]); o.w = pk2(v[1], v[0]); *(u32x4*)(base + (L - 8 - p0)) = o; }
            else { o.x = pk2(v[0], v[1]); o.y = pk2(v[2], v[3]); o.z = pk2(v[4], v[5]); o.w = pk2(v[6], v[7]); *(u32x4*)(base + (L + p0)) = o; }
          }
      }
    } else if (mode == EM_INPROJ) {
      const float* rstd1 = (const float*)(ws + O_RSTD1) + (size_t)slice * TS;
      if (u.swap) {
        u16* hyT = (u16*)(ws + O_HYT);
        f32x4 rr[2][2];
#pragma unroll
        for (int bj = 0; bj < 2; ++bj) { rr[bj][0] = *(const f32x4*)(rstd1 + col0 + bj * 128); rr[bj][1] = *(const f32x4*)(rstd1 + col0 + bj * 128 + 4); }
        __builtin_amdgcn_sched_barrier(0);
#pragma unroll
        for (int bj = 0; bj < 2; ++bj) {
          const int tok0 = col0 + bj * 128;
#pragma unroll
          for (int ai = 0; ai < 2; ++ai)
#pragma unroll
            for (int m = 0; m < 4; ++m) {
              const int ch = row0 + ai * 128 + m * 16 - 4608;
              const f32x4 a = acc[ai][bj][m][0] * rr[bj][0], b = acc[ai][bj][m][1] * rr[bj][1];
              u32x4 o; o.x = pk2(a[0], a[1]); o.y = pk2(a[2], a[3]); o.z = pk2(b[0], b[1]); o.w = pk2(b[2], b[3]);
              *(u32x4*)(hyT + (size_t)ch * TS + tok0) = o;
            }
        }
      } else {
        u16* qkv = (u16*)(ws + O_QKV); u16* sg = (u16*)(ws + O_SG + (size_t)(slice & 1) * SG_BYTES);
        const bool isg = (u.pn >= 30);
        float rsv[2][4];
#pragma unroll
        for (int ai = 0; ai < 2; ++ai)
#pragma unroll
          for (int m = 0; m < 4; ++m) rsv[ai][m] = rstd1[row0 + ai * 128 + m * 16];
        __builtin_amdgcn_sched_barrier(0);
#pragma unroll
        for (int ai = 0; ai < 2; ++ai)
#pragma unroll
          for (int m = 0; m < 4; ++m) {
            const int row = row0 + ai * 128 + m * 16; const float rs = rsv[ai][m];
#pragma unroll
            for (int bj = 0; bj < 2; ++bj) {
              const int c = col0 + bj * 128;
              f32x4 a = acc[ai][bj][m][0] * rs, b = acc[ai][bj][m][1] * rs;
              if (isg) {
#pragma unroll
                for (int e = 0; e < 4; ++e) { a[e] = __builtin_amdgcn_rcpf(1.0f + __expf(-a[e])); b[e] = __builtin_amdgcn_rcpf(1.0f + __expf(-b[e])); }
              }
              u32x4 o; o.x = pk2(a[0], a[1]); o.y = pk2(a[2], a[3]); o.z = pk2(b[0], b[1]); o.w = pk2(b[2], b[3]);
              if (isg) *(u32x4*)(sg + (size_t)row * 2048 + (c - 7680)) = o; else *(u32x4*)(qkv + (size_t)row * 4608 + c) = o;
            }
          }
      }
    } else if (mode == EM_AB || mode == EM_HBR) {
      const u16* sg = (const u16*)(ws + O_SG + (size_t)(slice & 1) * SG_BYTES) + (mode == EM_HBR ? 1024 : 0); u16* mg = (u16*)(ws + O_MG) + (size_t)slice * TS * 1024;
#pragma unroll
      for (int g8 = 0; g8 < 4; ++g8) {
        const int ai = g8 >> 1, m0 = (g8 & 1) * 2;
        u32x4 sv[2][2], pv[2][2];
#pragma unroll
        for (int mm = 0; mm < 2; ++mm)
#pragma unroll
          for (int bj = 0; bj < 2; ++bj) {
            const int row = row0 + ai * 128 + (m0 + mm) * 16, c = col0 + bj * 128;
            sv[mm][bj] = *(const u32x4*)(sg + (size_t)row * 2048 + c);
            if (mode == EM_HBR) pv[mm][bj] = *(const u32x4*)(mg + (size_t)row * 1024 + c);
          }
        __builtin_amdgcn_sched_barrier(0);
#pragma unroll
        for (int mm = 0; mm < 2; ++mm)
#pragma unroll
          for (int bj = 0; bj < 2; ++bj) {
            const int m = m0 + mm, row = row0 + ai * 128 + m * 16, c = col0 + bj * 128;
            const u32x4 sx = sv[mm][bj];
            const f32x4 a = acc[ai][bj][m][0], b = acc[ai][bj][m][1];
            float v[8] = {a[0] * lo16(sx.x), a[1] * hi16(sx.x), a[2] * lo16(sx.y), a[3] * hi16(sx.y), b[0] * lo16(sx.z), b[1] * hi16(sx.z), b[2] * lo16(sx.w), b[3] * hi16(sx.w)};
            if (mode == EM_HBR) { const u32x4 p = pv[mm][bj];
              v[0] += lo16(p.x); v[1] += hi16(p.x); v[2] += lo16(p.y); v[3] += hi16(p.y); v[4] += lo16(p.z); v[5] += hi16(p.z); v[6] += lo16(p.w); v[7] += hi16(p.w); }
            u32x4 o; o.x = pk2(v[0], v[1]); o.y = pk2(v[2], v[3]); o.z = pk2(v[4], v[5]); o.w = pk2(v[6], v[7]);
            *(u32x4*)(mg + (size_t)row * 1024 + c) = o;
          }
        __builtin_amdgcn_sched_barrier(0);
      }
    } else if (mode == EM_OUT) {
      const float* xin = (u.pm < 256) ? P->in[I_XP] : P->in[I_XS] - (size_t)65536 * DM;
      u16* x2b = (u16*)(ws + O_X2B);
      float* ssq = (float*)(ws + O_SSQ2);
#pragma unroll
      for (int g8 = 0; g8 < 4; ++g8) {
        const int ai = g8 >> 1, m0 = (g8 & 1) * 2;
        f32x4 xa[2][2][2];
#pragma unroll
        for (int mm = 0; mm < 2; ++mm)
#pragma unroll
          for (int bj = 0; bj < 2; ++bj) {
            const float* xp = xin + (size_t)(row0 + ai * 128 + (m0 + mm) * 16) * DM + col0 + bj * 128;
            xa[mm][bj][0] = *(const f32x4*)xp; xa[mm][bj][1] = *(const f32x4*)(xp + 4);
          }
        __builtin_amdgcn_sched_barrier(0);
#pragma unroll
        for (int mm = 0; mm < 2; ++mm) {
          const int m = m0 + mm, row = row0 + ai * 128 + m * 16; float sq = 0.f;
#pragma unroll
          for (int bj = 0; bj < 2; ++bj) {
            const int c = col0 + bj * 128;
            const f32x4 a = acc[ai][bj][m][0] + xa[mm][bj][0], b = acc[ai][bj][m][1] + xa[mm][bj][1];
            u32x4 o; o.x = pk2(a[0], a[1]); o.y = pk2(a[2], a[3]); o.z = pk2(b[0], b[1]); o.w = pk2(b[2], b[3]);
            *(u32x4*)(x2b + (size_t)row * DM + c) = o;
            sq += a[0] * a[0] + a[1] * a[1] + a[2] * a[2] + a[3] * a[3] + b[0] * b[0] + b[1] * b[1] + b[2] * b[2] + b[3] * b[3];
          }
          sq += __shfl_xor(sq, 16); sq += __shfl_xor(sq, 32);
          if (fq == 0) ssq[(size_t)(u.pn * 4 + wc) * TALL + row] = sq;
        }
        __builtin_amdgcn_sched_barrier(0);
      }
    } else if (mode == EM_FF1) {
      const float* rs2 = (const float*)(ws + O_RSTD2) + (size_t)slice * TS; u16* hb = (u16*)(ws + O_HB + (size_t)(slice & 1) * HB_BYTES);
      float rsv[2][4];
#pragma unroll
      for (int ai = 0; ai < 2; ++ai)
#pragma unroll
        for (int m = 0; m < 4; ++m) rsv[ai][m] = rs2[row0 + ai * 128 + m * 16];
      __builtin_amdgcn_sched_barrier(0);
#pragma unroll
      for (int ai = 0; ai < 2; ++ai)
#pragma unroll
        for (int m = 0; m < 4; ++m) {
          const int row = row0 + ai * 128 + m * 16; const float rs = rsv[ai][m];
#pragma unroll
          for (int bj = 0; bj < 2; ++bj) {
            const int c = col0 + bj * 128;
            f32x4 a = acc[ai][bj][m][0] * rs, b = acc[ai][bj][m][1] * rs;
#pragma unroll
            for (int e = 0; e < 4; ++e) { a[e] = fmaxf(a[e], 0.f); a[e] *= a[e]; b[e] = fmaxf(b[e], 0.f); b[e] *= b[e]; }
            u32x4 o; o.x = pk2(a[0], a[1]); o.y = pk2(a[2], a[3]); o.z = pk2(b[0], b[1]); o.w = pk2(b[2], b[3]);
            *(u32x4*)(hb + (size_t)row * DFF + c) = o;
          }
        }
    } else {
      float* xo = P->out + (size_t)slice * TS * DM; const u16* x2b = (const u16*)(ws + O_X2B) + (size_t)slice * TS * DM;
#pragma unroll
      for (int ai = 0; ai < 2; ++ai) {
        u32x4 xv[4][2];
#pragma unroll
        for (int m = 0; m < 4; ++m)
#pragma unroll
          for (int bj = 0; bj < 2; ++bj) xv[m][bj] = *(const u32x4*)(x2b + (size_t)(row0 + ai * 128 + m * 16) * DM + col0 + bj * 128);
        __builtin_amdgcn_sched_barrier(0);
#pragma unroll
        for (int m = 0; m < 4; ++m) {
          const int row = row0 + ai * 128 + m * 16;
#pragma unroll
          for (int bj = 0; bj < 2; ++bj) {
            float* d = xo + (size_t)row * DM + col0 + bj * 128;
            const u32x4 x4 = xv[m][bj];
            f32x4 o0 = acc[ai][bj][m][0], o1 = acc[ai][bj][m][1];
            o0[0] += lo16(x4.x); o0[1] += hi16(x4.x); o0[2] += lo16(x4.y); o0[3] += hi16(x4.y); o1[0] += lo16(x4.z); o1[1] += hi16(x4.z); o1[2] += lo16(x4.w); o1[3] += hi16(x4.w);
            *(f32x4*)d = o0; *(f32x4*)(d + 4) = o1;
          }
        }
        __builtin_amdgcn_sched_barrier(0);
      }
    }
  }
};

__device__ __forceinline__ void run_gemm(const Params& P, LAS unsigned char* lds, const u16* A, const u16* Bt, int M, int N, int K, int mode, int slice, int slo, int shi) {
  pg8::Gemm g; g.A = A; g.Bt = Bt; g.M = M; g.N = N; g.K = K;
  pg8::StaticOrder S; S.init(M, N, (int)gridDim.x, (int)blockIdx.x, slo, shi);
  Epi E; E.mode = mode; E.slice = slice; E.P = &P; { unsigned char* w = P.ws; LAUNDER_S(w); E.wsl = w; }
  pg8::gemm_phase<Epi>(lds, g, S, E);
}

__device__ __forceinline__ float red2pi(float x) { const float k = rintf(x * 0.15915494309189535f); float r = fmaf(-k, 6.28125f, x); return fmaf(-k, 1.9353071795864769e-3f, r); }
__device__ __forceinline__ float psin(float x) { const float r = red2pi(x); const float r2 = r * r;
  const float hx = 0.5f * r, h2 = hx * hx;
  const float sh = hx * (1.0f + h2 * (-1.6666667e-1f + h2 * (8.3333333e-3f + h2 * (-1.9841270e-4f + h2 * (2.7557319e-6f + h2 * (-2.5052108e-8f))))));
  const float ch = 1.0f + h2 * (-0.5f + h2 * (4.1666667e-2f + h2 * (-1.3888889e-3f + h2 * (2.4801587e-5f + h2 * (-2.7557319e-7f + h2 * 2.0876757e-9f)))));
  (void)r2; return 2.0f * sh * ch; }
__device__ __forceinline__ float pcos(float x) { const float r = red2pi(x); const float hx = 0.5f * r, h2 = hx * hx;
  const float sh = hx * (1.0f + h2 * (-1.6666667e-1f + h2 * (8.3333333e-3f + h2 * (-1.9841270e-4f + h2 * (2.7557319e-6f + h2 * (-2.5052108e-8f))))));
  return 1.0f - 2.0f * sh * sh; }
__device__ __forceinline__ void transpose_tile(const float* W, int K, int N, u16* WT, int ldo, const float* g, int tile, LAS float* scr) {
  int tid = threadIdx.x; LAUNDER_V(tid); const int ntn = N / 64, kb = tile / ntn, nb = tile % ntn, k0 = kb * 64, n0 = nb * 64;
#pragma unroll
  for (int i = 0; i < 8; ++i) { const int kk = (tid >> 6) + 8 * i, nn = tid & 63; float v = W[(size_t)(k0 + kk) * N + n0 + nn]; if (g) v *= g[k0 + kk]; scr[kk * 65 + nn] = v; }
  __syncthreads();
  { const int n = tid >> 3, c = tid & 7; const LAS float* s = scr + (8 * c) * 65 + n;
    u32x4 o; o.x = pk2(s[0], s[65]); o.y = pk2(s[130], s[195]); o.z = pk2(s[260], s[325]); o.w = pk2(s[390], s[455]);
    *(u32x4*)(WT + (size_t)(n0 + n) * ldo + k0 + 8 * c) = o; }
  __syncthreads();
}

__device__ __forceinline__ void phase_prep(const Params& P, LAS unsigned char* lds) {
  unsigned char* ws = P.ws; LAUNDER_S(ws); int tid = threadIdx.x; LAUNDER_V(tid); const int bid = blockIdx.x, G = gridDim.x;
  LAS float* scr = (LAS float*)lds;
  {
    const int T_IN = 16 * 152, T_AB = 8 * 16, T_HB = 16 * 16, T_OUT = 16 * 16, T_F1 = 16 * 64, T_F2 = 64 * 16, T_W4 = 1 * 64;
    const int NT = T_IN + T_AB + T_HB + T_OUT + T_F1 + T_F2 + T_W4;
    for (int it = bid; it < NT; it += G) {
      int r = it; const float* W; int K, N, ldo; size_t off; const float* gg = nullptr;
      if (r < T_IN) { W = P.in[I_WIN]; K = 1024; N = INW; off = O_WIN; ldo = 1024; gg = P.in[I_GMIX]; }
      else if ((r -= T_IN) < T_AB) { W = P.in[I_WAB]; K = 512; N = 1024; off = O_WAB; ldo = 512; }
      else if ((r -= T_AB) < T_HB) { W = P.in[I_WHB]; K = 1024; N = 1024; off = O_WHB; ldo = 1024; }
      else if ((r -= T_HB) < T_OUT) { W = P.in[I_WOUT]; K = 1024; N = 1024; off = O_WOUT; ldo = 1024; }
      else if ((r -= T_OUT) < T_F1) { W = P.in[I_WF1]; K = 1024; N = 4096; off = O_WF1; ldo = 1024; gg = P.in[I_GMLP]; }
      else if ((r -= T_F1) < T_F2) { W = P.in[I_WF2]; K = 4096; N = 1024; off = O_WF2; ldo = 4096; }
      else { r -= T_F2; W = P.in[I_FW4]; K = 64; N = 4096; off = O_W4; ldo = 256; }
      transpose_tile(W, K, N, (u16*)(ws + off), ldo, gg, r, scr);
    }
    for (int i = bid * 512 + tid; i < 4096 * 24; i += G * 512) { const int n = i / 24, c = i % 24; unsigned z0 = 0u; LAUNDER_V(z0); *(u32x4*)((u16*)(ws + O_W4) + (size_t)n * 256 + 64 + 8 * c) = (u32x4){z0, z0, z0, z0}; }
  }
  {
    const int wave = tid >> 6, lane = tid & 63; u16* xb = (u16*)(ws + O_XB); float* rstd1 = (float*)(ws + O_RSTD1);
    for (int chunk = bid; chunk < TALL / 32; chunk += G) {
#pragma unroll 1
      for (int rr = 0; rr < 4; ++rr) {
        const int row = chunk * 32 + wave * 4 + rr;
        const float* src = row < 65536 ? P.in[I_XP] + (size_t)row * DM : P.in[I_XS] + (size_t)(row - 65536) * DM;
        f32x4 v[4]; float s = 0.f;
#pragma unroll
        for (int j = 0; j < 4; ++j) { v[j] = *(const f32x4*)(src + 4 * lane + 256 * j); s += v[j][0] * v[j][0] + v[j][1] * v[j][1] + v[j][2] * v[j][2] + v[j][3] * v[j][3]; }
#pragma unroll
        for (int o = 1; o < 64; o <<= 1) s += __shfl_xor(s, o);
#pragma unroll
        for (int j = 0; j < 4; ++j) { u32x2 o; o.x = pk2(v[j][0], v[j][1]); o.y = pk2(v[j][2], v[j][3]); *(u32x2*)(xb + (size_t)row * DM + 4 * lane + 256 * j) = o; }
        if (lane == 0) rstd1[row] = rsqrtf(s * (1.0f / 1024.0f) + 1e-6f);
      }
    }
  }
  if (bid == 0) {
    float* bt = (float*)(ws + O_BIAS);
    for (int i = tid; i < 12 * 129; i += 512) {
      const int h = i / 129, e = i % 129, delta = e - 64, gi = h >> 2, dil = 1 << (2 * gi), rel = delta * dil;
      const int side = rel > 0 ? 16 : 0, n = rel < 0 ? -rel : rel;
      int bucket;
      if (n < 8) bucket = n; else { int lg = 8 + (int)(__log2f((float)n * 0.125f) * (8.0f / 7.0f)); bucket = lg < 15 ? lg : 15; }
      bt[i] = P.in[I_RELB][(side + bucket) * 12 + h];
    }
  }
  {
    LAS float* zf = scr + 4160; LAS float* ha = zf + 8 * 36; LAS float* hb = ha + 8 * 64;
    const int pp = tid >> 6, j = tid & 63; u16* h3 = (u16*)(ws + O_H3);
    const float* w1 = P.in[I_FW1]; const float* w2 = P.in[I_FW2]; const float* w3 = P.in[I_FW3];
    const float fr = P.in[I_FFR][j], b1 = P.in[I_FB1][j], b2 = P.in[I_FB2][j], b3 = P.in[I_FB3][j];
    for (int it = bid; it < NPOS / 8; it += G) {
      const int r = it * 8 + pp; const int L = r < 2048 ? 2048 : 16384; const int i = r < 2048 ? r : r - 2048;
      if (j < 33) {
        const float ang = (6.2831853071795864f * (float)i) / (float)L; float z;
        if (j == 0) z = (float)i / (float)(L - 1);
        else { const int bi = (j - 1) & 15; const float band = 1e-4f + (float)bi * ((15.0f - 1e-4f) / 15.0f); z = (j <= 16) ? pcos(band * ang) : -psin(band * ang); }
        zf[pp * 36 + j] = z;
      }
      __syncthreads();
      { float a = b1;
_Pragma("unroll 3")
        for (int k = 0; k < 33; ++k) a += zf[pp * 36 + k] * w1[k * 64 + j]; ha[pp * 64 + j] = psin(fr * a); }
      __syncthreads();
      { float a = b2;
_Pragma("unroll 4")
        for (int k = 0; k < 64; ++k) a += ha[pp * 64 + k] * w2[k * 64 + j]; hb[pp * 64 + j] = psin(fr * a); }
      __syncthreads();
      { float a = b3;
_Pragma("unroll 4")
        for (int k = 0; k < 64; ++k) a += hb[pp * 64 + k] * w3[k * 64 + j]; const float v = psin(fr * a);
        u16* d = h3 + (size_t)r * 256; d[j] = (u16)(pk2(v, 0.f) & 0xffffu); d[64 + j] = 0; d[128 + j] = 0; d[192 + j] = 0; }
      __syncthreads();
    }
  }
}

constexpr int KROW = 272;
constexpr int KHALF = 256 * KROW;
__device__ __forceinline__ void stage_kv(const u16* src_base_  , int b, int L, int dil, int r, int m0, int M, LAS unsigned char* img, const float* gk, int ht) {
  const GAS u16* src_base = (const GAS u16*)src_base_;
  const int dch = ht & 15;
  float gv[8];
  if (gk) {
#pragma unroll
    for (int e = 0; e < 8; ++e) gv[e] = gk[dch * 8 + e];
  }
  u32x4 vv[16];
#pragma unroll
  for (int it = 0; it < 16; ++it) {
    const int kl = (ht >> 4) + 16 * it; int m = m0 - 64 + kl; m = m < 0 ? 0 : (m > M - 1 ? M - 1 : m);
    vv[it] = *(const GAS u32x4*)(src_base + (size_t)(b * L + m * dil + r) * 4608 + dch * 8);
  }
#pragma unroll
  for (int it = 0; it < 16; ++it) {
    const int kl = (ht >> 4) + 16 * it, m = m0 - 64 + kl; const bool valid = (m >= 0) && (m < M);
    u32x4 v = vv[it];
    if (!valid) { v.x = 0u; LAUNDER_V(v.x); v.y = v.x; v.z = v.x; v.w = v.x; }
    if (gk) {
      float f[8] = {lo16(v.x), hi16(v.x), lo16(v.y), hi16(v.y), lo16(v.z), hi16(v.z), lo16(v.w), hi16(v.w)};
      float s = 0.f;
#pragma unroll
      for (int e = 0; e < 8; ++e) s += f[e] * f[e];
      s += __shfl_xor(s, 1); s += __shfl_xor(s, 2); s += __shfl_xor(s, 4); s += __shfl_xor(s, 8);
      const float rs = rsqrtf(s * (1.0f / 128.0f) + 1e-6f);
      v.x = pk2(f[0] * rs * gv[0], f[1] * rs * gv[1]); v.y = pk2(f[2] * rs * gv[2], f[3] * rs * gv[3]);
      v.z = pk2(f[4] * rs * gv[4], f[5] * rs * gv[5]); v.w = pk2(f[6] * rs * gv[6], f[7] * rs * gv[7]);
    }
    *(LAS u32x4*)(img + kl * KROW + dch * 16) = v;
  }
}

__device__ __forceinline__ void attn_item(const Params& P, int slice, int item, LAS unsigned char* lds) {
  unsigned char* ws = P.ws; LAUNDER_S(ws); int tid = threadIdx.x; LAUNDER_V(tid);
  const int wave = __builtin_amdgcn_readfirstlane(tid >> 6), lane = tid & 63, half = wave >> 2, wq = wave & 3, ht = tid & 255, qn = lane & 31, h = lane >> 5;
  const int L = slice < 4 ? 2048 : 16384;
  const int hi = item * 2 + half, gi = hi >> 9, rem = hi & 511, g = rem >> 7, ci = rem & 127;
  const int dil = 1 << (2 * gi), M = L / dil, cps = L >> 7, b = ci / cps, cr = ci % cps, cpr = M >> 7, r = cr / cpr, chunk = cr % cpr, m0 = chunk * 128, head = gi * 4 + g;
  const u16* qkv = (const u16*)(ws + O_QKV);
  LAS unsigned char* img = lds + half * KHALF;
  LAS float* bl = (LAS float*)(lds + 2 * KHALF + half * 1024);
  stage_kv(qkv + 1536 + head * 128, b, L, dil, r, m0, M, img, P.in[I_GK], ht);
  if (ht < 129) bl[ht] = ((const float*)(ws + O_BIAS))[head * 129 + ht];
  const int mq = m0 + 32 * wq + qn, tokq = b * L + mq * dil + r;
  bf16x8 Qf[8];
  {
    u32x4 qv[8]; float s = 0.f;
#pragma unroll
    for (int ks = 0; ks < 8; ++ks) { qv[ks] = *(const u32x4*)(qkv + (size_t)tokq * 4608 + head * 128 + 16 * ks + 8 * h);
      const float f0 = lo16(qv[ks].x), f1 = hi16(qv[ks].x), f2 = lo16(qv[ks].y), f3 = hi16(qv[ks].y), f4 = lo16(qv[ks].z), f5 = hi16(qv[ks].z), f6 = lo16(qv[ks].w), f7 = hi16(qv[ks].w);
      s += f0 * f0 + f1 * f1 + f2 * f2 + f3 * f3 + f4 * f4 + f5 * f5 + f6 * f6 + f7 * f7; }
    s += __shfl_xor(s, 32);
    const float rs = rsqrtf(s * (1.0f / 128.0f) + 1e-6f) * 0.08838834764831845f;
    const float* gq = P.in[I_GQ];
#pragma unroll
    for (int ks = 0; ks < 8; ++ks) {
      const f32x4 g0 = *(const f32x4*)(gq + 16 * ks + 8 * h), g1 = *(const f32x4*)(gq + 16 * ks + 8 * h + 4);
      u32x4 o; o.x = pk2(lo16(qv[ks].x) * rs * g0[0], hi16(qv[ks].x) * rs * g0[1]); o.y = pk2(lo16(qv[ks].y) * rs * g0[2], hi16(qv[ks].y) * rs * g0[3]);
      o.z = pk2(lo16(qv[ks].z) * rs * g1[0], hi16(qv[ks].z) * rs * g1[1]); o.w = pk2(lo16(qv[ks].w) * rs * g1[2], hi16(qv[ks].w) * rs * g1[3]);
      Qf[ks] = __builtin_bit_cast(bf16x8, o);
    }
  }
  __syncthreads();
  f32x16 sc[5];
#pragma unroll
  for (int kt = 0; kt < 5; ++kt) {
#pragma unroll
    for (int i = 0; i < 16; ++i) sc[kt][i] = 0.f;
    const LAS unsigned char* kp = img + (32 * wq + 32 * kt + qn) * KROW + 16 * h;
#pragma unroll
    for (int ks = 0; ks < 8; ++ks) { const bf16x8 a = *(const LAS bf16x8*)(kp + 32 * ks); sc[kt] = __builtin_amdgcn_mfma_f32_32x32x16_bf16(a, Qf[ks], sc[kt], 0, 0, 0); }
  }
  float mx = -3.0e38f;
#pragma unroll
  for (int kt = 0; kt < 5; ++kt)
#pragma unroll
    for (int i = 0; i < 16; ++i) {
      const int keyl = 32 * kt + (i & 3) + 8 * (i >> 2) + 4 * h; const int delta = keyl - 64 - qn; const int km = m0 - 64 + 32 * wq + keyl;
      const bool valid = (delta >= -64) && (delta <= 64) && (km >= 0) && (km < M);
      int bi = delta + 64; bi = bi < 0 ? 0 : (bi > 128 ? 128 : bi);
      const float sv = valid ? sc[kt][i] + bl[bi] : -1e30f;
      sc[kt][i] = sv; mx = fmaxf(mx, sv);
    }
  mx = fmaxf(mx, __shfl_xor(mx, 32));
  float den = 0.f;
#pragma unroll
  for (int kt = 0; kt < 5; ++kt)
#pragma unroll
    for (int i = 0; i < 16; ++i) { const float pe = __expf(sc[kt][i] - mx); sc[kt][i] = pe; den += pe; }
  den += __shfl_xor(den, 32);
  const float inv = 1.0f / den;
  if (h == 0) ((float*)(ws + O_LSE))[((size_t)(gi * 4 + g)) * TS + b * L + r * M + mq] = mx + __logf(den);
  __syncthreads();
  stage_kv(qkv + 3072 + head * 128, b, L, dil, r, m0, M, img, nullptr, ht);
  __syncthreads();
  f32x16 oa[4];
#pragma unroll
  for (int dt = 0; dt < 4; ++dt)
#pragma unroll
    for (int i = 0; i < 16; ++i) oa[dt][i] = 0.f;
  const int i16 = lane & 15, q4 = i16 >> 2, p4 = i16 & 3, blk = (lane >> 4) & 1;
#pragma unroll
  for (int kt = 0; kt < 5; ++kt)
#pragma unroll
    for (int s = 0; s < 2; ++s) {
      u32x4 pb; pb.x = pk2(sc[kt][8 * s + 0] * inv, sc[kt][8 * s + 1] * inv); pb.y = pk2(sc[kt][8 * s + 2] * inv, sc[kt][8 * s + 3] * inv);
      pb.z = pk2(sc[kt][8 * s + 4] * inv, sc[kt][8 * s + 5] * inv); pb.w = pk2(sc[kt][8 * s + 6] * inv, sc[kt][8 * s + 7] * inv);
      const bf16x8 bfr = __builtin_bit_cast(bf16x8, pb);
      const LAS unsigned char* vp = img + (32 * wq + 32 * kt + 16 * s + 4 * h + q4) * KROW + 2 * (16 * blk + 4 * p4);
#pragma unroll
      for (int dt = 0; dt < 4; ++dt) {
        const s16x4 lo = __builtin_amdgcn_ds_read_tr16_b64_v4i16((LAS s16x4*)(vp + 64 * dt));
        const s16x4 hi4 = __builtin_amdgcn_ds_read_tr16_b64_v4i16((LAS s16x4*)(vp + 64 * dt + 8 * KROW));
        const bf16x8 a = __builtin_shufflevector(lo, hi4, 0, 1, 2, 3, 4, 5, 6, 7);
        oa[dt] = __builtin_amdgcn_mfma_f32_32x32x16_bf16(a, bfr, oa[dt], 0, 0, 0);
      }
    }
  u16* o3 = (u16*)(ws + O_O3) + ((size_t)gi * TS + tokq) * 512 + g * 128;
#pragma unroll
  for (int dt = 0; dt < 4; ++dt)
#pragma unroll
    for (int g4 = 0; g4 < 4; ++g4) {
      u32x2 o; o.x = pk2(oa[dt][4 * g4], oa[dt][4 * g4 + 1]); o.y = pk2(oa[dt][4 * g4 + 2], oa[dt][4 * g4 + 3]);
      *(u32x2*)(o3 + 32 * dt + 8 * g4 + 4 * h) = o;
    }
  __syncthreads();
}

constexpr int ZBLK = 272;
constexpr int ZS_BYTES = 128 * ZBLK + 512;
constexpr int WIN_COPY = 544, WIN_BYTES = 8 * WIN_COPY;
constexpr int CONV_GRP = 4;
constexpr int CONV_ZERO_OFF = 2 * ZS_BYTES + 2 * 2 * CONV_GRP * WIN_BYTES;

struct Sc4Raw { u32x2 v; unsigned pr, nr; };
__device__ __forceinline__ Sc4Raw sc4_load(const u16* row_, int tok) {
  const GAS u16* row = (const GAS u16*)row_;
  Sc4Raw r; r.v = *(const GAS u32x2*)(row + (unsigned)tok);
  const int ip = tok > 0 ? tok - 1 : 0, in = tok + 4 < TS ? tok + 4 : TS - 1;
  r.pr = (unsigned)row[(unsigned)ip]; r.nr = (unsigned)row[(unsigned)in];
  return r;
}
__device__ __forceinline__ f32x4 sc4_apply(const Sc4Raw& r, int tok, int L, float w0, float w1, float w2, float bb) {
  const float c0 = lo16(r.v.x), c1 = hi16(r.v.x), c2 = lo16(r.v.y), c3 = hi16(r.v.y);
  const float pv = ((tok & (L - 1)) == 0) ? 0.f : bf2f(r.pr);
  const float nx = (((tok + 4) & (L - 1)) == 0) ? 0.f : bf2f(r.nr);
  f32x4 o; o[0] = w0 * pv + w1 * c0 + w2 * c1 + bb; o[1] = w0 * c0 + w1 * c1 + w2 * c2 + bb; o[2] = w0 * c1 + w1 * c2 + w2 * c3 + bb; o[3] = w0 * c2 + w1 * c3 + w2 * nx + bb;
  return o;
}
__device__ __forceinline__ f32x4 sc4(const u16* row_, int tok, int L, float w0, float w1, float w2, float bb) { const Sc4Raw r = sc4_load(row_, tok); return sc4_apply(r, tok, L, w0, w1, w2, bb); }

__device__ __forceinline__ void conv_item(const Params& P, int slice, int item, LAS unsigned char* lds) {
  unsigned char* ws = P.ws; LAUNDER_S(ws); int tid = threadIdx.x; LAUNDER_V(tid);
  const int wave = __builtin_amdgcn_readfirstlane(tid >> 6), lane = tid & 63, chh = wave >> 2, w4 = wave & 3, wm = w4 & 1, wn = (w4 >> 1) ^ chh  , ht = tid & 255, l16 = lane & 15, kc = lane >> 4;
  const int c = item * 2 + chh;
  const int L = slice < 4 ? 2048 : 16384, nb = slice < 4 ? 8 : 1, nblk = 128 / nb, nbsh = slice < 4 ? 3 : 0;
  const u16* hyT = (const u16*)(ws + O_HYT);
  LAS unsigned char* Zs = lds + chh * ZS_BYTES;
  LAS unsigned char* Wn = lds + 2 * ZS_BYTES + chh * 2 * CONV_GRP * WIN_BYTES;
  const float* wsh = P.in[I_WSH]; const float* bsh = P.in[I_BSH];
  if (tid < 64) *(LAS unsigned*)(lds + CONV_ZERO_OFF + 4 * tid) = 0u;
  {
    const u16* row = hyT + (size_t)c * TS; const float w0 = wsh[c], w1 = wsh[3072 + c], w2 = wsh[6144 + c], bb = bsh[c];
#pragma unroll
    for (int hh = 0; hh < 2; ++hh) {
      Sc4Raw zr[4][2];
#pragma unroll
      for (int i4 = 0; i4 < 4; ++i4) { const int tok = 8 * (ht + 256 * (4 * hh + i4)); zr[i4][0] = sc4_load(row, tok); zr[i4][1] = sc4_load(row, tok + 4); }
      __builtin_amdgcn_sched_barrier(0);
#pragma unroll
      for (int i4 = 0; i4 < 4; ++i4) {
        const int tok = 8 * (ht + 256 * (4 * hh + i4));
        const f32x4 a = sc4_apply(zr[i4][0], tok, L, w0, w1, w2, bb), bq = sc4_apply(zr[i4][1], tok + 4, L, w0, w1, w2, bb);
        const int Bk = tok >> 7, bs = Bk / nblk;
        u32x4 o; o.x = pk2(a[0], a[1]); o.y = pk2(a[2], a[3]); o.z = pk2(bq[0], bq[1]); o.w = pk2(bq[2], bq[3]);
        *(LAS u32x4*)(Zs + Bk * ZBLK + bs * 32 + 2 * (tok & 127)) = o;
      }
      __builtin_amdgcn_sched_barrier(0);
    }
  }
  const int nsteps = 2 * nblk - 1, dmin = -(nblk - 1);
  const int aroA = (l16 & 7) * WIN_COPY + 2 * (128 + 8 * kc - 64 * wm - (l16 & 8));
  const int wdo = (ht >> 5) * WIN_COPY + 4 * (ht & 31);

  for (int order = 0; order < 2; ++order) {
    const GAS u16* G = (const GAS u16*)(ws + (L == 2048 ? O_G2K : O_G16K)) + (size_t)(order * 1024 + c) * (size_t)(2 * L);
    f32x4 acc[4][4];
#pragma unroll
    for (int a = 0; a < 4; ++a)
#pragma unroll
      for (int b2 = 0; b2 < 4; ++b2) acc[a][b2] = (f32x4){0.f, 0.f, 0.f, 0.f};
    unsigned wl[8];
    const int ub = L - 129 + 2 * (ht & 31) - (ht >> 5);
#define CONV_LOADWIN(dd) do { _Pragma("unroll") for (int q = 0; q < 4; ++q) { const int u = ub + 64 * q - 128 * (dd); \
      int i0 = u + (u > L - 1 ? 1 : 0), i1 = u + 1 + (u >= L - 1 ? 1 : 0); i0 = i0 < 0 ? 0 : (i0 > 2 * L - 1 ? 2 * L - 1 : i0); i1 = i1 < 0 ? 0 : (i1 > 2 * L - 1 ? 2 * L - 1 : i1); \
      wl[2 * q] = (unsigned)G[(unsigned)i0]; wl[2 * q + 1] = (unsigned)G[(unsigned)i1]; } } while (0)
#define CONV_STOREWIN(t) do { LAS unsigned char* wd_ = Wn + ((((t) >> 2) & 1) * CONV_GRP + ((t) & 3)) * WIN_BYTES + wdo; _Pragma("unroll") for (int q = 0; q < 8; ++q) LAUNDER_V(wl[q]); _Pragma("unroll") for (int q = 0; q < 4; ++q) \
      *(LAS unsigned*)(wd_ + 128 * q) = wl[2 * q] | (wl[2 * q + 1] << 16); } while (0)
#define CONV_ROT() do { } while (0)
    { unsigned w4[CONV_GRP][8];
#pragma unroll
      for (int t0 = 0; t0 < CONV_GRP; ++t0) { CONV_LOADWIN(dmin + t0);
#pragma unroll
        for (int q = 0; q < 8; ++q) w4[t0][q] = wl[q]; }
      __builtin_amdgcn_sched_barrier(0);
#pragma unroll
      for (int t0 = 0; t0 < CONV_GRP; ++t0) {
#pragma unroll
        for (int q = 0; q < 8; ++q) wl[q] = w4[t0][q];
        CONV_STOREWIN(t0); }
    }
    __syncthreads();
    const int q0 = 2 * wn, q1 = 2 * wn + 1;
    const int lo0 = ((32 * q0) >> nbsh) - (nblk - 1), hi0 = (32 * q0 + 31) >> nbsh, lo1 = ((32 * q1) >> nbsh) - (nblk - 1), hi1 = (32 * q1 + 31) >> nbsh;
    const int n0 = 32 * q0 + l16, n1 = 32 * q1 + l16;
    const int bk0 = n0 >> nbsh, bs0 = n0 & (nb - 1); (void)n1;
    const LAS unsigned char* zb0 = Zs + (bs0 * nblk) * ZBLK + bs0 * 32 + 16 * kc;
#define bk1 (bk0 + (32 >> nbsh))
#define zb1 zb0
    bf16x8 fa[10], fb[8];
#define CONV_MFMA(a_, b_, c_) __builtin_amdgcn_mfma_f32_16x16x32_bf16((a_), (b_), (c_), 0, 0, 0)
#define CONV_WB(st) (Wn + ((((st) >> 2) & 1) * CONV_GRP + ((st) & 3)) * WIN_BYTES + aroA)
#define CONV_BPH(T, H, e) ((((bk##T) + (H) * (16 >> nbsh) - (e)) >= 0 && ((bk##T) + (H) * (16 >> nbsh) - (e)) < nblk) ? zb##T + ((bk##T) + (H) * (16 >> nbsh) - (e)) * ZBLK : (const LAS unsigned char*)(lds + CONV_ZERO_OFF))
#define CONV_TILESTEP(TT, NBP0, NBP1, PF, NWB, HM) do { \
      const LAS unsigned char* nb0_ = (NBP0); const LAS unsigned char* nb1_ = (NBP1); const LAS unsigned char* nwb_ = (NWB); \
      __builtin_amdgcn_sched_barrier(0); __builtin_amdgcn_s_setprio(1); \
      _Pragma("unroll") for (int ks = 0; ks < 4; ++ks) { \
        _Pragma("unroll") for (int hh = 0; hh < 2; ++hh) { \
          if ((HM) & (1 << hh)) { _Pragma("unroll") for (int mt = 0; mt < 4; ++mt) acc[mt][2 * TT + hh] = CONV_MFMA(fa[2 * ks - mt + 3], fb[4 * hh + ks], acc[mt][2 * TT + hh]); } \
          fb[4 * hh + ks] = *(const LAS bf16x8*)((hh ? nb1_ : nb0_) + 64 * ks); \
        } \
        if (PF) { fa[2 * ks] = *(const LAS bf16x8*)(nwb_ + 32 * (2 * ks - 3)); fa[2 * ks + 1] = *(const LAS bf16x8*)(nwb_ + 32 * (2 * ks - 2)); } \
      } \
      if (PF) { fa[8] = *(const LAS bf16x8*)(nwb_ + 32 * 5); fa[9] = *(const LAS bf16x8*)(nwb_ + 32 * 6); } \
      _Pragma("unroll") for (int ks = 0; ks < 4; ++ks) { __builtin_amdgcn_sched_group_barrier(0x008, 4, 0); __builtin_amdgcn_sched_group_barrier(0x100, 1, 0); \
        __builtin_amdgcn_sched_group_barrier(0x008, 4, 0); __builtin_amdgcn_sched_group_barrier(0x100, (PF) ? 3 : 1, 0); } \
      if (PF) __builtin_amdgcn_sched_group_barrier(0x100, 2, 0); \
      __builtin_amdgcn_sched_barrier(0); __builtin_amdgcn_s_setprio(0); \
    } while (0)
#define CONV_HEAD() const int step = d - dmin; if (step + CONV_GRP < nsteps) CONV_LOADWIN(d + CONV_GRP); __builtin_amdgcn_sched_barrier(0)
#define CONV_TAIL() if (step + CONV_GRP < nsteps) CONV_STOREWIN(step + CONV_GRP); if ((step & 1) == 1 || step + 1 == nsteps) __syncthreads()
    for (int d = dmin; d < lo0; ++d) { CONV_HEAD(); CONV_TAIL(); }
    {
      const LAS unsigned char* wb = CONV_WB(lo0 - dmin); const LAS unsigned char* bp0 = CONV_BPH(0, 0, lo0); const LAS unsigned char* bp1 = CONV_BPH(0, 1, lo0);
#pragma unroll
      for (int k = 0; k < 10; ++k) fa[k] = *(const LAS bf16x8*)(wb + 32 * (k - 3));
#pragma unroll
      for (int ks = 0; ks < 4; ++ks) { fb[ks] = *(const LAS bf16x8*)(bp0 + 64 * ks); fb[4 + ks] = *(const LAS bf16x8*)(bp1 + 64 * ks); }
    }
    const int hw = 16 >> nbsh;
#define CONV_DS(x) ({ int t_ = (x); LAUNDER_S(t_); t_; })
#define CONV_NB1(H) ((d + 1 <= hi0) ? CONV_BPH(0, H, d + 1) : CONV_BPH(1, H, d + 1))
    for (int d = CONV_DS(lo0); d < lo0 + hw; ++d) { CONV_HEAD(); CONV_TILESTEP(0, CONV_BPH(0, 0, d + 1), CONV_BPH(0, 1, d + 1), 1, CONV_WB(step + 1), 1); CONV_TAIL(); }
    for (int d = CONV_DS(lo0 + hw); d < lo1; ++d) { CONV_HEAD(); CONV_TILESTEP(0, CONV_BPH(0, 0, d + 1), CONV_BPH(0, 1, d + 1), 1, CONV_WB(step + 1), 3); CONV_TAIL(); }
    for (int d = CONV_DS(lo1); d < lo1 + hw; ++d) { CONV_HEAD(); CONV_TILESTEP(0, CONV_BPH(1, 0, d), CONV_BPH(1, 1, d), 0, Wn, 3);
      CONV_TILESTEP(1, CONV_NB1(0), CONV_NB1(1), 1, CONV_WB(step + 1), 1); CONV_TAIL(); }
    for (int d = CONV_DS(lo1 + hw); d <= hi0 - hw; ++d) { CONV_HEAD(); CONV_TILESTEP(0, CONV_BPH(1, 0, d), CONV_BPH(1, 1, d), 0, Wn, 3);
      CONV_TILESTEP(1, CONV_NB1(0), CONV_NB1(1), 1, CONV_WB(step + 1), 3); CONV_TAIL(); }
    for (int d = CONV_DS(hi0 - hw + 1); d <= hi0; ++d) { CONV_HEAD(); CONV_TILESTEP(0, CONV_BPH(1, 0, d), CONV_BPH(1, 1, d), 0, Wn, 2);
      CONV_TILESTEP(1, CONV_NB1(0), CONV_NB1(1), 1, CONV_WB(step + 1), 3); CONV_TAIL(); }
    for (int d = CONV_DS(hi0 + 1); d <= hi1 - hw; ++d) { CONV_HEAD(); CONV_TILESTEP(1, CONV_BPH(1, 0, d + 1), CONV_BPH(1, 1, d + 1), 1, CONV_WB(step + 1), 3); CONV_TAIL(); }
    for (int d = CONV_DS(hi1 - hw + 1); d <= hi1; ++d) { CONV_HEAD(); CONV_TILESTEP(1, CONV_BPH(1, 0, d + 1), CONV_BPH(1, 1, d + 1), 1, CONV_WB(step + 1), 2); CONV_TAIL(); }
#undef CONV_DS
#undef CONV_NB1
    { int dl_ = hi1 + 1; LAUNDER_S(dl_); for (int d = dl_; d < nblk; ++d) { CONV_HEAD(); CONV_TAIL(); } }
#undef bk1
#undef zb1
#undef CONV_MFMA
#undef CONV_WB
#undef CONV_BPH
#undef CONV_TILESTEP
#undef CONV_HEAD
#undef CONV_TAIL

#undef CONV_ROT
#undef CONV_LOADWIN
#undef CONV_STOREWIN
    {
      const int gc = 1024 * (order + 1) + c; const u16* grow = hyT + (size_t)gc * TS;
      const float w0 = wsh[gc], w1 = wsh[3072 + gc], w2 = wsh[6144 + gc], bb = bsh[gc], skip = P.in[I_FSK][order * 1024 + c];
      GAS u16* zt = (GAS u16*)(ws + O_ZT) + (size_t)c * TS;
      int te = threadIdx.x; LAUNDER_V(te); const int l16 = te & 15, kc = (te >> 4) & 3;
#pragma unroll
      for (int nt = 0; nt < 2; ++nt) {
        Sc4Raw gr[2][4];
#pragma unroll
        for (int hh = 0; hh < 2; ++hh) {
          const int n = 32 * (2 * wn + nt) + 16 * hh + l16, bk = n >> nbsh, bs = n & (nb - 1), Bo = bs * nblk + bk;
#pragma unroll
          for (int mt = 0; mt < 4; ++mt) gr[hh][mt] = sc4_load(grow, Bo * 128 + 64 * wm + 16 * mt + 4 * kc);
        }
        __builtin_amdgcn_sched_barrier(0);
#pragma unroll
        for (int hh = 0; hh < 2; ++hh) {
          const int n = 32 * (2 * wn + nt) + 16 * hh + l16, bk = n >> nbsh, bs = n & (nb - 1), Bo = bs * nblk + bk;
#pragma unroll
          for (int mt = 0; mt < 4; ++mt) {
            const int s0 = 64 * wm + 16 * mt + 4 * kc, tok = Bo * 128 + s0;
            LAS u32x2* zp = (LAS u32x2*)(Zs + Bo * ZBLK + bs * 32 + 2 * s0);
            const u32x2 zv = *zp; const f32x4 gt = sc4_apply(gr[hh][mt], tok, L, w0, w1, w2, bb);
            const f32x4 av = acc[mt][2 * nt + hh];
            const float y0 = gt[0] * (av[0] + skip * lo16(zv.x)), y1 = gt[1] * (av[1] + skip * hi16(zv.x));
            const float y2 = gt[2] * (av[2] + skip * lo16(zv.y)), y3 = gt[3] * (av[3] + skip * hi16(zv.y));
            u32x2 o; o.x = pk2(y0, y1); o.y = pk2(y2, y3);
            if (order == 0) *zp = o; else *(GAS u32x2*)(zt + (unsigned)tok) = o;
          }
        }
        __builtin_amdgcn_sched_barrier(0);
      }
    }
    __syncthreads();
  }
}

__device__ __forceinline__ void phase_combine(const Params& P, int slice, LAS unsigned char* lds) {
  unsigned char* ws = P.ws; LAUNDER_S(ws); int tid = threadIdx.x; LAUNDER_V(tid); const int bid = blockIdx.x, G = gridDim.x;
  const GAS float* lse = (const GAS float*)(ws + O_LSE); const GAS u16* o3 = (const GAS u16*)(ws + O_O3); GAS u16* att = (GAS u16*)(ws + O_ATT);
  const int Lc = slice < 4 ? 2048 : 16384;
  for (int idx0 = bid * 512 + tid; idx0 < TS * 64; idx0 += 2 * G * 512) {
    float l[2][3]; u32x4 ov[2][3]; int tokv[2], chv[2]; bool ok[2];
#pragma unroll
    for (int r = 0; r < 2; ++r) {
      int idx = idx0 + r * G * 512; ok[r] = idx < TS * 64; idx = ok[r] ? idx : idx0;
      const int tok = idx >> 6, ch = idx & 63, g = ch >> 4; tokv[r] = tok; chv[r] = ch;
      const int tl = tok & (Lc - 1), tb = tok - tl;
      l[r][0] = lse[(size_t)(0 + g) * TS + tok];
      l[r][1] = lse[(size_t)(4 + g) * TS + tb + (tl & 3) * (Lc >> 2) + (tl >> 2)];
      l[r][2] = lse[(size_t)(8 + g) * TS + tb + (tl & 15) * (Lc >> 4) + (tl >> 4)];
#pragma unroll
      for (int gi = 0; gi < 3; ++gi) ov[r][gi] = *(const GAS u32x4*)(o3 + ((size_t)gi * TS + tok) * 512 + ch * 8);
    }
    __builtin_amdgcn_sched_barrier(0);
#pragma unroll
    for (int r = 0; r < 2; ++r) {
      const float m = fmaxf(l[r][0], fmaxf(l[r][1], l[r][2])); float e0 = __expf(l[r][0] - m), e1 = __expf(l[r][1] - m), e2 = __expf(l[r][2] - m);
      const float inv = __builtin_amdgcn_rcpf(e0 + e1 + e2); e0 *= inv; e1 *= inv; e2 *= inv;
      const u32x4 a = ov[r][0], b = ov[r][1], cc = ov[r][2];
      u32x4 o;
      o.x = pk2(e0 * lo16(a.x) + e1 * lo16(b.x) + e2 * lo16(cc.x), e0 * hi16(a.x) + e1 * hi16(b.x) + e2 * hi16(cc.x));
      o.y = pk2(e0 * lo16(a.y) + e1 * lo16(b.y) + e2 * lo16(cc.y), e0 * hi16(a.y) + e1 * hi16(b.y) + e2 * hi16(cc.y));
      o.z = pk2(e0 * lo16(a.z) + e1 * lo16(b.z) + e2 * lo16(cc.z), e0 * hi16(a.z) + e1 * hi16(b.z) + e2 * hi16(cc.z));
      o.w = pk2(e0 * lo16(a.w) + e1 * lo16(b.w) + e2 * lo16(cc.w), e0 * hi16(a.w) + e1 * hi16(b.w) + e2 * hi16(cc.w));
      if (ok[r]) *(GAS u32x4*)(att + (size_t)tokv[r] * 512 + chv[r] * 8) = o;
    }
    __builtin_amdgcn_sched_barrier(0);
  }
  const GAS u16* zt = (const GAS u16*)(ws + O_ZT); GAS u16* zr = (GAS u16*)(ws + O_ZR); LAS u16* tl = (LAS u16*)lds;
  for (int tile0 = bid; tile0 < 16 * 256; tile0 += 8 * G) {
    u32x4 tv[8];
#pragma unroll
    for (int kk = 0; kk < 8; ++kk) { int tile = tile0 + kk * G; tile = tile < 16 * 256 ? tile : tile0;
      const int cb = tile >> 8, tb = tile & 255; tv[kk] = *(const GAS u32x4*)(zt + (size_t)(cb * 64 + (tid >> 3)) * TS + tb * 64 + 8 * (tid & 7)); }
    __builtin_amdgcn_sched_barrier(0);
#pragma unroll
    for (int kk = 0; kk < 8; ++kk) {
      const int tile = tile0 + kk * G;
      if (tile < 16 * 256) {
        const int cb = tile >> 8, tb = tile & 255, c0 = cb * 64, t0 = tb * 64;
        { const int cc = tid >> 3, k = tid & 7; LAS unsigned* d = (LAS unsigned*)(tl + cc * 72 + 8 * k); d[0] = tv[kk].x; d[1] = tv[kk].y; d[2] = tv[kk].z; d[3] = tv[kk].w; }
        __syncthreads();
        { const int tt = tid >> 3, k = tid & 7; unsigned e[8];
#pragma unroll
          for (int j = 0; j < 8; ++j) e[j] = tl[(8 * k + j) * 72 + tt];
          u32x4 o; o.x = e[0] | (e[1] << 16); o.y = e[2] | (e[3] << 16); o.z = e[4] | (e[5] << 16); o.w = e[6] | (e[7] << 16);
          *(GAS u32x4*)(zr + (size_t)(t0 + tt) * 1024 + c0 + 8 * k) = o; }
        __syncthreads();
      }
    }
  }
}

constexpr int NPHASE = 2 + 3 * NSL + 2 + (NSL + 1);
#ifndef PHM
#define PHM 0xffff
#endif
__global__ void __launch_bounds__(512) fwd_megakernel(Params P) {
  extern __shared__ __attribute__((aligned(16))) unsigned char shm[];
  LAS unsigned char* lds = (LAS unsigned char*)shm;
  cg::grid_group grid = cg::this_grid();
  if (blockIdx.x == 0 && threadIdx.x == 0) __hip_atomic_store((unsigned*)(P.ws + O_CTR), 0u, __ATOMIC_RELAXED, __HIP_MEMORY_SCOPE_AGENT);
  for (int ph = P.ph_lo; ph < P.ph_hi; ++ph) {
    unsigned char* ws = P.ws; LAUNDER_S(ws);
    if (ph == 0) { if (PHM & 1) phase_prep(P, lds); }
    else {
      const int q = ph - 2, s = q / 3, k = q % 3;
      if (ph >= 2 && ph < 2 + 3 * NSL && k == 0) {
        const int NATT = 768, NCONV = 512;
        for (int it = blockIdx.x; it < NATT + NCONV; it += gridDim.x) { if (it < NATT) attn_item(P, s, it, lds); else conv_item(P, s, it - NATT, lds); }
      } else if (ph >= 2 && ph < 2 + 3 * NSL && k == 1) {
        phase_combine(P, s, lds);
      } else {
        const int PH_OUT = 2 + 3 * NSL, c = ph - (PH_OUT + 2);
        int ng;
        if (ph == 1) ng = 2; else if (ph < PH_OUT) ng = (s < NSL - 1) ? 3 : 2; else if (ph == PH_OUT) ng = 1; else if (ph == PH_OUT + 1) ng = 0; else ng = (c == 0 || c == NSL) ? 1 : 2;
        if (ph == PH_OUT + 1) {
          const GAS float* sp = (const GAS float*)(ws + O_SSQ2); GAS float* r2 = (GAS float*)(ws + O_RSTD2);
          int t3 = threadIdx.x; LAUNDER_V(t3);
          for (int row = blockIdx.x * 512 + t3; row < TALL; row += gridDim.x * 512) {
            float pq[16];
#pragma unroll
            for (int q2 = 0; q2 < 16; ++q2) pq[q2] = sp[(size_t)q2 * TALL + row];
            float sst = 0.f;
#pragma unroll
            for (int q2 = 0; q2 < 16; ++q2) sst += pq[q2];
            r2[row] = rsqrtf(sst * (1.0f / 1024.0f) + 1e-6f); }
        }
#pragma nounroll
        for (int gi = 0; gi < ng; ++gi) {
          const u16* A; const u16* Bt; int M = TS, N = 1024, K = 1024, mode, slo = 0, shi = 0, sl = 0;
          if (ph == 1 && gi == 0) { A = (const u16*)(ws + O_H3); Bt = (const u16*)(ws + O_W4); M = NPOS; N = 4096; K = 256; mode = EM_FILT; slo = 0; shi = 1 << 30; }
          else if (ph == 1 || (ph < PH_OUT && gi == 2)) { sl = (ph == 1) ? 0 : s + 1; A = (const u16*)(ws + O_XB) + (size_t)sl * TS * DM; Bt = (const u16*)(ws + O_WIN); N = INW; mode = EM_INPROJ; slo = 18; shi = 30; }
          else if (ph < PH_OUT && gi == 0) { sl = s; A = (const u16*)(ws + O_ATT); Bt = (const u16*)(ws + O_WAB); K = 512; mode = EM_AB; }
          else if (ph < PH_OUT) { sl = s; A = (const u16*)(ws + O_ZR); Bt = (const u16*)(ws + O_WHB); mode = EM_HBR; }
          else if (ph == PH_OUT) { A = (const u16*)(ws + O_MG); Bt = (const u16*)(ws + O_WOUT); M = TALL; mode = EM_OUT; }
          else if ((c > 0 && gi == 0) || c == NSL) { sl = c - 1; A = (const u16*)(ws + O_HB + (size_t)(sl & 1) * HB_BYTES); Bt = (const u16*)(ws + O_WF2); K = DFF; mode = EM_FF2; }
          else { sl = c; A = (const u16*)(ws + O_X2B) + (size_t)sl * TS * DM; Bt = (const u16*)(ws + O_WF1); N = DFF; mode = EM_FF1; }
          run_gemm(P, lds, A, Bt, M, N, K, mode, sl, slo, shi);
        }
      }
    }
    if (ph + 1 < P.ph_hi) {
      asm volatile("s_waitcnt vmcnt(0) lgkmcnt(0)" ::: "memory");
      __syncthreads();
      if (ph == P.ph_lo) {
        if (threadIdx.x < 64) { __builtin_amdgcn_fence(__ATOMIC_RELEASE, "agent"); asm volatile("s_waitcnt vmcnt(0)" ::: "memory"); }
        __syncthreads();
        grid.sync();
        __builtin_amdgcn_fence(__ATOMIC_ACQUIRE, "agent");
        asm volatile("s_waitcnt vmcnt(0)" ::: "memory");
      } else {
        if (threadIdx.x == 0) {
          unsigned* ctr = (unsigned*)(ws + O_CTR);
          const unsigned target = (unsigned)(ph - P.ph_lo) * gridDim.x;
          __builtin_amdgcn_fence(__ATOMIC_RELEASE, "agent");
          asm volatile("s_waitcnt vmcnt(0)" ::: "memory");
          __hip_atomic_fetch_add(ctr, 1u, __ATOMIC_RELAXED, __HIP_MEMORY_SCOPE_AGENT);
          while (__hip_atomic_load(ctr, __ATOMIC_RELAXED, __HIP_MEMORY_SCOPE_AGENT) < target) __builtin_amdgcn_s_sleep(2);
          __builtin_amdgcn_fence(__ATOMIC_ACQUIRE, "agent");
          asm volatile("s_waitcnt vmcnt(0)" ::: "memory");
        }
        __syncthreads();
      }
    }
  }
}

extern "C" void kernel_launch(void* const* d_in, const int* in_sizes, int n_in, void* d_out, int out_size, void* d_ws, size_t ws_size, hipStream_t stream) {
  static int grid_blocks = 0;
  if (!grid_blocks) {
    if (n_in != 24 || ws_size < WS_END) { fprintf(stderr, "kernel_launch: unexpected n_in %d or ws_size %zu (< %zu)\n", n_in, ws_size, (size_t)WS_END); grid_blocks = -1; return; }
    int dev = 0, cus = 0, per_cu = 0;
    hipGetDevice(&dev);
    hipDeviceGetAttribute(&cus, hipDeviceAttributeMultiprocessorCount, dev);
    if (hipFuncSetAttribute((const void*)fwd_megakernel, hipFuncAttributeMaxDynamicSharedMemorySize, LDS_BYTES) != hipSuccess) { fprintf(stderr, "hipFuncSetAttribute failed\n"); grid_blocks = -1; return; }
    hipOccupancyMaxActiveBlocksPerMultiprocessor(&per_cu, (const void*)fwd_megakernel, 512, LDS_BYTES);
    if (per_cu < 1) per_cu = 1;
    grid_blocks = cus * per_cu;
  }
  if (grid_blocks < 0) return;
  Params p{};
  for (int i = 0; i < 24; ++i) p.in[i] = (const float*)d_in[i];
  p.out = (float*)d_out; p.ws = (unsigned char*)d_ws;
#if N_LAUNCH_MODE == 1
  p.ph_lo = 0; p.ph_hi = NPHASE;
  void* args[] = {&p};
  hipError_t e = hipLaunchCooperativeKernel((const void*)fwd_megakernel, dim3(grid_blocks), dim3(512), args, LDS_BYTES, stream);
  if (e != hipSuccess) fprintf(stderr, "cooperative launch failed: %s (grid %d)\n", hipGetErrorString(e), grid_blocks);
#else
  for (int ph = 0; ph < NPHASE; ++ph) {
    p.ph_lo = ph; p.ph_hi = ph + 1;
    hipLaunchKernelGGL(fwd_megakernel, dim3(grid_blocks), dim3(512), LDS_BYTES, stream, p);
  }
#endif
}
```
